# Optimizing an MI355X kernel written in HIP

```python
import jax, jax.numpy as jnp
from jax import lax
import numpy as np

D_MODEL = 1024
BATCH = 32
SEQ = 2048
DEPTH = 1

A_GROUPS = 8
A_GROUP_DIM = 64
A_WIDTH = A_GROUPS * A_GROUP_DIM
CHUNK = 128
N_HEADS = 8
N_KV_HEADS = 2
HEAD_DIM = 64
Q_GROUP = N_HEADS // N_KV_HEADS
B_WIDTH = N_HEADS * HEAD_DIM
KV_WIDTH = N_KV_HEADS * HEAD_DIM
WINDOW = 128
BLOCK = 128
SPAN = BLOCK + 2 * WINDOW
N_BUCKETS = 32
MAX_DISTANCE = 128
N_EXPERTS = 16
EXPERT_FF = 2048
CAPACITY_FACTOR = 2
EPS = 1e-6
IN_COLS = 2 * A_WIDTH + B_WIDTH + 2 * KV_WIDTH + 2 * D_MODEL
SPLITS = (A_WIDTH, 2 * A_WIDTH, 2 * A_WIDTH + B_WIDTH, 2 * A_WIDTH + B_WIDTH + KV_WIDTH,
          2 * A_WIDTH + B_WIDTH + 2 * KV_WIDTH, 2 * A_WIDTH + B_WIDTH + 2 * KV_WIDTH + D_MODEL)

kernel_name = "hybrid_gmlp_swa_ec_moe_encoder"


def rms_norm(x, g):
    xf = x.astype(jnp.float32)
    y = xf * lax.rsqrt(jnp.mean(xf * xf, axis=-1, keepdims=True) + EPS)
    return (y * g.astype(jnp.float32)).astype(x.dtype)


def t5_bucket(rel):
    nb = N_BUCKETS // 2
    max_exact = nb // 2
    ret = (rel > 0).astype(np.int32) * nb
    n = np.abs(rel)
    large = max_exact + (np.log(np.maximum(n, 1) / max_exact) / np.log(MAX_DISTANCE / max_exact)
                         * (nb - max_exact)).astype(np.int32)
    large = np.minimum(large, nb - 1)
    return (ret + np.where(n < max_exact, n, large)).astype(np.int32)


def chunked_spatial_gating(u, v, vnorm_g, w_spatial, b_spatial):
    B, S, _ = v.shape
    v = rms_norm(v, vnorm_g)
    vc = v.reshape(B, S // CHUNK, CHUNK, A_GROUPS, A_GROUP_DIM)
    mixed = jnp.einsum('gpq,bcqgd->bcpgd', w_spatial, vc) + b_spatial.T[None, None, :, :, None]
    return u * mixed.reshape(B, S, A_WIDTH)


def windowed_gqa(q, k, v, sink, rel_table):
    B, S = q.shape[0], q.shape[1]
    nb = S // BLOCK
    qb = q.reshape(B, nb, BLOCK, N_KV_HEADS, Q_GROUP, HEAD_DIM).transpose(1, 0, 3, 4, 2, 5)
    pad = ((0, 0), (WINDOW, WINDOW), (0, 0), (0, 0))
    kp = jnp.pad(k, pad).transpose(0, 2, 1, 3).astype(jnp.float32)
    vp = jnp.pad(v, pad).transpose(0, 2, 1, 3).astype(jnp.float32)
    rel = (np.arange(SPAN)[None, :] - WINDOW) - np.arange(BLOCK)[:, None]
    band = jnp.asarray(np.abs(rel) <= WINDOW)
    bias = rel_table[t5_bucket(rel)].astype(jnp.float32)
    bias = bias.transpose(2, 0, 1).reshape(N_KV_HEADS, Q_GROUP, BLOCK, SPAN)
    sink_f = sink.astype(jnp.float32).reshape(N_KV_HEADS, Q_GROUP, 1, 1)
    scale = HEAD_DIM ** -0.5

    def one_block(args):
        n, qblk = args
        start = n * BLOCK
        kblk = lax.dynamic_slice_in_dim(kp, start, SPAN, axis=2)
        vblk = lax.dynamic_slice_in_dim(vp, start, SPAN, axis=2)
        pos = start - WINDOW + jnp.arange(SPAN)
        valid = band & ((pos >= 0) & (pos < S))[None, :]
        s = jnp.einsum('bkgqd,bkjd->bkgqj', qblk.astype(jnp.float32), kblk) * scale + bias
        s = jnp.where(valid, s, -jnp.inf)
        m = jnp.maximum(jnp.max(s, axis=-1, keepdims=True), sink_f)
        p = jnp.exp(s - m)
        denom = jnp.sum(p, axis=-1, keepdims=True) + jnp.exp(sink_f - m)
        o = jnp.einsum('bkgqj,bkjd->bkgqd', p, vblk) / denom
        return o.astype(q.dtype)

    out = lax.map(one_block, (jnp.arange(nb), qb))
    return out.transpose(1, 0, 4, 2, 3, 5).reshape(B, S, B_WIDTH)


def expert_choice_moe(h, w_router, w_gate_e, w_up_e, w_down_e):
    B, S, _ = h.shape
    cap = CAPACITY_FACTOR * S // N_EXPERTS
    logits = jnp.einsum('bsd,de->bse', h.astype(jnp.float32), w_router.astype(jnp.float32))
    aff = jax.nn.softmax(logits, axis=-1)
    gates, idx = lax.top_k(aff.transpose(0, 2, 1), cap)
    bidx = jnp.arange(B)[:, None, None]
    xg = h[bidx, idx]
    hid = jax.nn.silu(jnp.einsum('becd,edf->becf', xg, w_gate_e)) * jnp.einsum('becd,edf->becf', xg, w_up_e)
    out = jnp.einsum('becf,efd->becd', hid, w_down_e) * gates[..., None].astype(h.dtype)
    return jnp.zeros_like(h).at[bidx, idx].add(out)


def setup_inputs(seed: int = 0) -> dict:
    key = jax.random.key(seed)
    ks = jax.random.split(key, 20)
    f32 = jnp.float32
    L = DEPTH
    nrm = lambda k, shape, s: jax.random.normal(k, shape, f32) * s
    return {
        "x": jax.random.normal(ks[0], (BATCH, SEQ, D_MODEL), f32),
        "norm_mix_g": 1.0 + nrm(ks[1], (L, D_MODEL), 0.02),
        "w_in": nrm(ks[2], (L, D_MODEL, IN_COLS), D_MODEL ** -0.5),
        "b_gate": nrm(ks[3], (L, 2 * D_MODEL), 0.02),
        "vnorm_g": 1.0 + nrm(ks[4], (L, A_WIDTH), 0.02),
        "w_spatial": nrm(ks[5], (L, A_GROUPS, CHUNK, CHUNK), CHUNK ** -0.5),
        "b_spatial": 1.0 + nrm(ks[6], (L, A_GROUPS, CHUNK), 0.02),
        "q_norm_g": 1.0 + nrm(ks[7], (L, HEAD_DIM), 0.02),
        "k_norm_g": 1.0 + nrm(ks[8], (L, HEAD_DIM), 0.02),
        "attn_sink": nrm(ks[9], (L, N_HEADS), 1.0),
        "rel_bias_table": nrm(ks[10], (N_BUCKETS, N_HEADS), 0.5),
        "w_proj_a": nrm(ks[11], (L, A_WIDTH, D_MODEL), A_WIDTH ** -0.5),
        "w_proj_b": nrm(ks[12], (L, B_WIDTH, D_MODEL), B_WIDTH ** -0.5),
        "w_out": nrm(ks[13], (L, D_MODEL, D_MODEL), D_MODEL ** -0.5),
        "norm_ffn_g": 1.0 + nrm(ks[14], (L, D_MODEL), 0.02),
        "w_router": nrm(ks[15], (L, D_MODEL, N_EXPERTS), D_MODEL ** -0.5),
        "w_gate_e": nrm(ks[16], (L, N_EXPERTS, D_MODEL, EXPERT_FF), D_MODEL ** -0.5),
        "w_up_e": nrm(ks[17], (L, N_EXPERTS, D_MODEL, EXPERT_FF), D_MODEL ** -0.5),
        "w_down_e": nrm(ks[18], (L, N_EXPERTS, EXPERT_FF, D_MODEL), EXPERT_FF ** -0.5),
    }


def reference(x, norm_mix_g, w_in, b_gate, vnorm_g, w_spatial, b_spatial, q_norm_g, k_norm_g,
              attn_sink, rel_bias_table, w_proj_a, w_proj_b, w_out, norm_ffn_g, w_router,
              w_gate_e, w_up_e, w_down_e):
    B, S, _ = x.shape
    for l in range(DEPTH):
        h = rms_norm(x, norm_mix_g[l])
        z = jnp.einsum('bsd,dc->bsc', h, w_in[l])
        u_a, v_a, q, k, v, g_a, g_b = jnp.split(z, SPLITS, axis=-1)
        a = chunked_spatial_gating(jax.nn.gelu(u_a), jax.nn.gelu(v_a), vnorm_g[l], w_spatial[l], b_spatial[l])
        q = rms_norm(q.reshape(B, S, N_HEADS, HEAD_DIM), q_norm_g[l])
        k = rms_norm(k.reshape(B, S, N_KV_HEADS, HEAD_DIM), k_norm_g[l])
        v = v.reshape(B, S, N_KV_HEADS, HEAD_DIM)
        o = windowed_gqa(q, k, v, attn_sink[l], rel_bias_table)
        gate_a = jax.nn.sigmoid(g_a + b_gate[l, :D_MODEL])
        gate_b = jax.nn.sigmoid(g_b + b_gate[l, D_MODEL:])
        merged = gate_a * jnp.einsum('bsa,ad->bsd', a, w_proj_a[l]) + gate_b * jnp.einsum('bsa,ad->bsd', o, w_proj_b[l])
        x = x + jnp.einsum('bsd,de->bse', merged, w_out[l])
        h = rms_norm(x, norm_ffn_g[l])
        x = x + expert_choice_moe(h, w_router[l], w_gate_e[l], w_up_e[l], w_down_e[l])
    return x
```

```cpp
#include <hip/hip_runtime.h>
#include <stdint.h>
#include <stdio.h>

#define LAS __attribute__((address_space(3)))
#define GAS __attribute__((address_space(1)))
typedef unsigned short bf16;
typedef short bf16x8 __attribute__((ext_vector_type(8)));
typedef short s16x4 __attribute__((ext_vector_type(4)));
typedef float f32x4 __attribute__((ext_vector_type(4)));
typedef float f32x2 __attribute__((ext_vector_type(2)));
typedef unsigned u32x4 __attribute__((ext_vector_type(4)));
typedef unsigned u32x2 __attribute__((ext_vector_type(2)));

constexpr int NB = 32, S = 2048, D = 1024, T = NB * S;
constexpr int AW = 512, BW = 512, KVW = 128, INC = 3840, NE = 16, FF = 2048, CAP = 256, NSLOT = NE * NB * CAP;
constexpr float EPS = 1e-6f;
constexpr int NWAVES = 8, NTHREADS = 512;

constexpr size_t MiB = 1u << 20;
constexpr size_t WS_CTL = 0, CTL_ZERO_BYTES = 64 * 1024;
constexpr size_t WS_WIN = 1 * MiB, WS_WPROJ = 9 * MiB, WS_WOUT = 11 * MiB, WS_WSP = 13 * MiB, WS_WRH = 13 * MiB + 512 * 1024, WS_WRL = 13 * MiB + 768 * 1024;
constexpr size_t WS_WDN = 14 * MiB, WS_WGU = 46 * MiB;
constexpr size_t WS_H = 206 * MiB, WS_AFF = 334 * MiB, WS_IDX = 338 * MiB, WS_GATEV = 338 * MiB + 512 * 1024, WS_RS = 339 * MiB, WS_RSTD = 339 * MiB + 512 * 1024, WS_RSTD0 = 339 * MiB + 768 * 1024;
constexpr size_t WS_UG = 340 * MiB, WS_VG = 404 * MiB, WS_Q = 468 * MiB, WS_K = 532 * MiB, WS_VB = 548 * MiB, WS_R = 564 * MiB, WS_GB = 692 * MiB, WS_AO = 820 * MiB;
constexpr size_t WS_MG = 340 * MiB, WS_HID = 340 * MiB, WS_INV = 852 * MiB, WS_X1B = 856 * MiB, WS_END = 984 * MiB;
constexpr size_t WS_H0F8 = 692 * MiB, WS_WIN8 = 760 * MiB;
constexpr size_t WS_Y = 596 * MiB;
constexpr float YSCALE = 16.0f;
constexpr float WSCALE = 32.0f;
constexpr size_t WS_IG1 = 512 * 1024;
constexpr int CW_TMO = 0, CW_BAR = 4096;

__device__ __forceinline__ float bf2f(unsigned b) { return __uint_as_float((b & 0xffffu) << 16); }
__device__ __forceinline__ float bfhi2f(unsigned w) { return __uint_as_float(w & 0xffff0000u); }
__device__ __forceinline__ float bflo2f(unsigned w) { return __uint_as_float(w << 16); }
__device__ __forceinline__ bf16 f2bf(float f) { unsigned u = __float_as_uint(f); u += 0x7fffu + ((u >> 16) & 1u); return (bf16)(u >> 16); }
__device__ __forceinline__ unsigned pk2(float lo, float hi) { unsigned r; asm volatile("v_cvt_pk_bf16_f32 %0, %1, %2" : "=v"(r) : "v"(lo), "v"(hi)); return r; }
__device__ __forceinline__ int t5_bucket(int rel) { const int n = rel < 0 ? -rel : rel; const int v = n < 8 ? n : 8 + (n >= 12) + (n >= 16) + (n >= 23) + (n >= 32) + (n >= 46) + (n >= 64) + (n >= 91); return (rel > 0 ? 16 : 0) + v; }
__device__ __forceinline__ float fast_exp(float x) { return __builtin_amdgcn_exp2f(x * 1.4426950408889634f); }
__device__ __forceinline__ float fast_rcp(float x) { return __builtin_amdgcn_rcpf(x); }
__device__ __forceinline__ float min1(float a, float b) { float r; asm("v_min_f32 %0, %1, %2" : "=v"(r) : "v"(a), "v"(b)); return r; }
__device__ __forceinline__ float max1(float a, float b) { float r; asm("v_max_f32 %0, %1, %2" : "=v"(r) : "v"(a), "v"(b)); return r; }
__device__ __forceinline__ float clamp1(float x, float lo, float hi) { return __builtin_amdgcn_fmed3f(x, lo, hi); }
__device__ __forceinline__ float gelu_t(float x) { const float x2 = x * x; const float a = x * (-2.3022081981f - 0.1029432404f * x2); return x * fast_rcp(1.0f + __builtin_amdgcn_exp2f(a)); }

__device__ __forceinline__ int inv_bf16(int L) { return 128 * ((L >> 5) & 1) + 32 * (L >> 6) + 16 * ((L >> 2) & 1) + 4 * ((L >> 3) & 3) + (L & 3); }
__device__ __forceinline__ int inv_f32(int L) { return 128 * ((L >> 5) & 1) + 32 * (L >> 6) + 16 * ((L >> 4) & 1) + 4 * ((L >> 2) & 3) + (L & 3); }
__device__ __forceinline__ int inv_pair(int which, int L) { return 128 * which + 32 * (L >> 5) + 16 * ((L >> 2) & 1) + 4 * ((L >> 3) & 3) + (L & 3); }

#define XB_TMO      128
#define XB_XCNT(j)  (256  + 64 * (j))
#define XB_XSUB(j)  (1280 + 64 * (j))
#define XB_XGEN(j)  (2304 + 64 * (j))
#define XB_TOP      3328
#define XB_TOPGEN   3392
#define XCD_BAR_WORDS 3456
#define XB_SPIN_CAP (1u << 18)
__device__ __forceinline__ unsigned xb_ld(unsigned* p)              { return __hip_atomic_load(p, __ATOMIC_RELAXED, __HIP_MEMORY_SCOPE_AGENT); }
__device__ __forceinline__ unsigned xb_add(unsigned* p, unsigned v) { return __hip_atomic_fetch_add(p, v, __ATOMIC_RELAXED, __HIP_MEMORY_SCOPE_AGENT); }
__device__ __forceinline__ unsigned xb_xcc_id() { return (unsigned)__builtin_amdgcn_s_getreg((3 << 11) | 20) & 0xFu; }
#define XB_SPIN(cond, bar) do { unsigned _sp = 0; while (cond) { __builtin_amdgcn_s_sleep(1); \
    if ((++_sp & 255u) == 0u) { if (xb_ld(&(bar)[XB_TMO])) break; if (_sp > XB_SPIN_CAP) { atomicAdd(&(bar)[XB_TMO], 1u); break; } } } } while (0)
struct XcdBarrier { unsigned* bar; unsigned x; volatile LAS unsigned* st; };
__device__ __forceinline__ XcdBarrier xcd_barrier_post(unsigned* bar, volatile LAS unsigned* st) {
    XcdBarrier b; b.bar = bar; b.x = xb_xcc_id(); b.st = st;
    if (threadIdx.x == 0) (void)xb_add(&bar[XB_XCNT(b.x)], 1u);
    return b;
}
__device__ __forceinline__ void xcd_barrier_complete(unsigned* bar, unsigned x, unsigned& nloc, unsigned& nx) {
    const unsigned G = gridDim.x * gridDim.y * gridDim.z;
    unsigned sum, cnt, mine, sp = 0u;
    for (;;) {
        sum = 0u; cnt = 0u; mine = 0u;
#pragma unroll
        for (unsigned j = 0; j < 16; ++j) { const unsigned c = xb_ld(&bar[XB_XCNT(j)]); sum += c; cnt += (c > 0u) ? 1u : 0u; mine = (j == x) ? c : mine; }
        if (sum == G) break;
        __builtin_amdgcn_s_sleep(1);
        if ((++sp & 255u) == 0u) { if (xb_ld(&bar[XB_TMO])) break; if (sp > XB_SPIN_CAP) { atomicAdd(&bar[XB_TMO], 1u); break; } }
    }
    nloc = mine > 0u ? mine : 1u; nx = cnt > 0u ? cnt : 1u;
}
__device__ __forceinline__ void xcd_barrier(const XcdBarrier& b) {
    asm volatile("s_waitcnt vmcnt(0)" ::: "memory");
    __syncthreads();
    if (threadIdx.x == 0) {
        unsigned* bar = b.bar;
        __builtin_amdgcn_s_waitcnt(0);
        unsigned nloc = b.st[0], nx = b.st[1];
        if (nloc == 0u) { xcd_barrier_complete(bar, b.x, nloc, nx); b.st[0] = nloc; b.st[1] = nx; }
        const unsigned old = xb_add(&bar[XB_XSUB(b.x)], 1u);
        const unsigned gen = old / nloc;
        if (old + 1u == (gen + 1u) * nloc) {
            __builtin_amdgcn_fence(__ATOMIC_RELEASE, "agent");
            asm volatile("s_waitcnt vmcnt(0)" ::: "memory");
            const unsigned og = xb_add(&bar[XB_TOP], 1u);
            const unsigned tg = og / nx;
            if (og + 1u == (tg + 1u) * nx) xb_add(&bar[XB_TOPGEN], 1u);
            else XB_SPIN(xb_ld(&bar[XB_TOPGEN]) == tg, bar);
            __builtin_amdgcn_fence(__ATOMIC_ACQUIRE, "agent");
            xb_add(&bar[XB_XGEN(b.x)], 1u);
            asm volatile("s_waitcnt vmcnt(0)" ::: "memory");
        } else {
            XB_SPIN(xb_ld(&bar[XB_XGEN(b.x)]) == gen, bar);
            __builtin_amdgcn_fence(__ATOMIC_ACQUIRE, "agent");
            asm volatile("s_waitcnt vmcnt(0)" ::: "memory");
        }
    }
    __syncthreads();
}

namespace pg {
typedef int i32x4 __attribute__((ext_vector_type(4)));
typedef int i32x8 __attribute__((ext_vector_type(8)));
typedef double f64x2 __attribute__((ext_vector_type(2)));
constexpr int BM = 256, BK = 64, HALF = 128, HTB = HALF * BK * 2, STAGE_BYTES = 8 * HTB, NXCD = 8, WGM = 4;
__device__ __forceinline__ int lds_byte(int r, int c) { const int st = (r >> 4) * 2 + (c >> 5), rr = r & 15, cc = c & 31, ob = rr * 64 + cc * 2; return st * 1024 + (ob ^ (((ob >> 9) & 1) << 5)); }
__device__ __forceinline__ void stage_rc(int b, int& R, int& C) { const int st = b / 1024, sb = b % 1024, swz = sb ^ (((sb >> 9) & 1) << 5); R = (st >> 1) * 16 + swz / 64; C = (st & 1) * 32 + (swz % 64) / 2; }
struct Unit { int pm, pn; };
struct StaticOrder {
    int nM, nN, nwg, G, c, wgm, rev;
    __device__ __forceinline__ void init(int M, int N, int G_, int c_, int wgm_ = WGM, int rev_ = 0) { nM = M / BM; nN = N / BM; nwg = nM * nN; G = G_; c = c_; wgm = wgm_; rev = rev_; }
    __device__ __forceinline__ bool next(int i, Unit& u) const {
        const long L = (long)i * G + c; if (L >= nwg) return false;
        int wgid = (int)L; { const int q = nwg / NXCD, r = nwg % NXCD, xcd = wgid % NXCD, off = wgid / NXCD; wgid = (xcd < r ? xcd * (q + 1) : r * (q + 1) + (xcd - r) * q) + off; }
        const int nig = wgm * nN, gid = wgid / nig, fm = gid * wgm, gsz = (nM - fm) < wgm ? (nM - fm) : wgm;
        u.pm = fm + ((wgid % nig) % gsz); u.pn = (wgid % nig) / gsz; if (rev) u.pm = nM - 1 - u.pm; return true;
    }
};
struct Prob { const char* A; const int* idx; const char* Bt; int KB; int gshift; size_t gstride; };
constexpr int LTAB_OFF = STAGE_BYTES, LTAB_BYTES = 32 * 256 * 2, RSC_OFF = LTAB_OFF + LTAB_BYTES;

__device__ __forceinline__ const char* uni(const char* p) { const unsigned long long v = (unsigned long long)p; const unsigned lo = __builtin_amdgcn_readfirstlane((unsigned)v), hi = __builtin_amdgcn_readfirstlane((unsigned)(v >> 32)); return (const char*)(((unsigned long long)hi << 32) | lo); }
template <class Epi, bool FP8, bool GATHER, class Sched = StaticOrder>
__device__ __forceinline__ void gemm_phase(LAS unsigned char* lds, const Prob g, const Sched& S, const Epi& E) {
    const int tid = threadIdx.x, wid = __builtin_amdgcn_readfirstlane(tid >> 6), lane = tid & 63, wr = wid >> 2, wc = wid & 3, fr = lane & 15, fq = lane >> 4;
    const int KB = g.KB, nt = KB / (BK * 2);
    int R2[2], C2[2]; unsigned voffB[2];
#pragma unroll
    for (int i = 0; i < 2; ++i) { stage_rc(tid * 16 + i * 8192, R2[i], C2[i]); voffB[i] = (unsigned)(R2[i] * KB + C2[i] * 2); }
    const size_t kstep = (size_t)(BK * 2);
    const size_t hstep = (size_t)HALF * KB;
    const size_t tstep = 2 * hstep;
    const unsigned rowb = (unsigned)KB;
    const unsigned ldsw = (unsigned)wid * 1024u;
    const int aoff = lds_byte(wr * 64 + fr, fq * 8), boff = lds_byte(wc * 32 + fr, fq * 8);
#define PG_SA(b, h) (((b) * 2 + (h)) * HTB)
#define PG_SB(b, h) ((4 + (b) * 2 + (h)) * HTB)
#define PG_STAGE(bufoff, gbase, voff) do { _Pragma("unroll") for (int _i = 0; _i < 2; ++_i) \
        __builtin_amdgcn_global_load_lds((const unsigned*)(uni((const char*)(gbase)) + (voff)[_i]), (LAS unsigned*)(lds + (bufoff) + ldsw + _i * 8192), 16, 0, 0); } while (0)
#define PG_LD16(base, off) (*(const LAS i32x4*)(lds + (base) + (off)))
#define PG_CAT2(lo, hi) __builtin_shufflevector((lo), (hi), 0, 1, 2, 3, 4, 5, 6, 7)
#define PG_LDA(dst, b, h) do { _Pragma("unroll") for (int m = 0; m < 4; ++m) dst[m] = PG_CAT2(PG_LD16(la, PG_SA(b, h) + m * 2048), PG_LD16(la, PG_SA(b, h) + m * 2048 + 1024)); } while (0)
#define PG_LDB(dst, b, h) do { _Pragma("unroll") for (int n = 0; n < 2; ++n) dst[n] = PG_CAT2(PG_LD16(lb, PG_SB(b, h) - 65536 + n * 2048), PG_LD16(lb, PG_SB(b, h) - 65536 + n * 2048 + 1024)); } while (0)
#define PG_LO(x) __builtin_bit_cast(bf16x8, __builtin_shufflevector((x), (x), 0, 1, 2, 3))
#define PG_HI(x) __builtin_bit_cast(bf16x8, __builtin_shufflevector((x), (x), 4, 5, 6, 7))
#define PG_MMA(ai, bj, At, Bt) do { __builtin_amdgcn_s_setprio(1); _Pragma("unroll") for (int m = 0; m < 4; ++m) _Pragma("unroll") for (int n = 0; n < 2; ++n) { \
        if constexpr (FP8) acc[ai][bj][m][n] = __builtin_amdgcn_mfma_scale_f32_16x16x128_f8f6f4(Bt[n], At[m], acc[ai][bj][m][n], 0, 0, 0, 0, 0, 0); \
        else { acc[ai][bj][m][n] = __builtin_amdgcn_mfma_f32_16x16x32_bf16(PG_LO(Bt[n]), PG_LO(At[m]), acc[ai][bj][m][n], 0, 0, 0); \
               acc[ai][bj][m][n] = __builtin_amdgcn_mfma_f32_16x16x32_bf16(PG_HI(Bt[n]), PG_HI(At[m]), acc[ai][bj][m][n], 0, 0, 0); } } \
        __builtin_amdgcn_s_setprio(0); } while (0)
#define PG_WAIT_V(n) asm volatile("s_waitcnt vmcnt(" #n ")" ::: "memory")
#define PG_WAIT_L(n) asm volatile("s_waitcnt lgkmcnt(" #n ")" ::: "memory")
#define PG_BAR __builtin_amdgcn_s_barrier()
#define PG_SCHED __builtin_amdgcn_sched_barrier(0)
#define PG_AOFFS(dst, ord) do { _Pragma("unroll") for (int _h = 0; _h < 2; ++_h) _Pragma("unroll") for (int _i = 0; _i < 2; ++_i) \
        dst[_h][_i] = (unsigned)ltab[(ord) * 256 + _h * HALF + R2[_i]] * rowb + (unsigned)C2[_i] * 2u; } while (0)
    const LAS unsigned short* ltab = (const LAS unsigned short*)(lds + LTAB_OFF);
    if constexpr (GATHER) {
        Unit u0; for (int i = 0; i < 32 && S.next(i, u0); ++i) { if (tid < 256) ((LAS unsigned short*)(lds + LTAB_OFF))[i * 256 + tid] = (unsigned short)g.idx[u0.pm * BM + tid]; }
        __syncthreads();
    }
    if constexpr (Epi::PREP) { E.prep(tid); __syncthreads(); }
    Unit cur, nxt; int ui = 0;
    if (!S.next(0, cur)) return;

    f32x4 acc[2][2][4][2];
#define PG_ACC_INIT(u) do { if constexpr (Epi::INIT) { int t2 = tid; asm volatile("" : "+v"(t2)); E.init(acc, u, wr, wc, t2 & 15, (t2 & 63) >> 4); \
        _Pragma("unroll") for (int a = 0; a < 2; ++a) _Pragma("unroll") for (int b = 0; b < 2; ++b) _Pragma("unroll") for (int m = 0; m < 4; ++m) _Pragma("unroll") for (int n = 0; n < 2; ++n) asm volatile("" : "+v"(acc[a][b][m][n])); } \
      else { _Pragma("unroll") for (int a = 0; a < 2; ++a) _Pragma("unroll") for (int b = 0; b < 2; ++b) _Pragma("unroll") for (int m = 0; m < 4; ++m) _Pragma("unroll") for (int n = 0; n < 2; ++n) { \
            double z0_, z1_; asm volatile("v_mov_b64 %0, 0" : "=v"(z0_)); asm volatile("v_mov_b64 %0, 0" : "=v"(z1_)); acc[a][b][m][n] = __builtin_bit_cast(f32x4, (f64x2){z0_, z1_}); } } } while (0)
    PG_ACC_INIT(cur);
    i32x8 At[4], B0[2], B1[2];
    unsigned vA[2][2], vN[2][2];
    if constexpr (GATHER) { PG_AOFFS(vA, 0); }
    const char* cA = GATHER ? g.A : g.A + (size_t)cur.pm * tstep;
    const char* cB = g.Bt + (size_t)(cur.pm >> g.gshift) * g.gstride + (size_t)cur.pn * tstep;
#define PG_STAGE_A(bufoff, ptr, h) do { if constexpr (GATHER) { PG_STAGE(bufoff, ptr, vA[h]); } else { PG_STAGE(bufoff, (ptr) + (h) * hstep, voffB); } } while (0)
    PG_STAGE(PG_SB(0, 0), cB, voffB); PG_STAGE(PG_SB(0, 1), cB + hstep, voffB); PG_STAGE_A(PG_SA(0, 0), cA, 0); PG_STAGE_A(PG_SA(0, 1), cA, 1);
    if (wr == 1) PG_BAR;
    PG_WAIT_V(2); PG_BAR;
    PG_STAGE(PG_SB(1, 0), cB + kstep, voffB); PG_STAGE_A(PG_SA(1, 0), cA + kstep, 0); PG_STAGE(PG_SB(1, 1), cB + hstep + kstep, voffB);
    PG_WAIT_V(6); PG_BAR;
    for (;;) {
        const bool has_next = S.next(ui + 1, nxt);
        if constexpr (GATHER) { if (has_next) { PG_AOFFS(vN, ui + 1); } else {
#pragma unroll
            for (int _h = 0; _h < 2; ++_h)
#pragma unroll
                for (int _i = 0; _i < 2; ++_i) vN[_h][_i] = vA[_h][_i]; } }
        const char* nA = GATHER ? g.A : (has_next ? g.A + (size_t)nxt.pm * tstep : cA);
        const char* nB = has_next ? g.Bt + (size_t)(nxt.pm >> g.gshift) * g.gstride + (size_t)nxt.pn * tstep : cB;
#pragma unroll 1
        for (int t = 0; t < nt; t += 2) {
            const bool last = (t == nt - 2);
            unsigned la = (unsigned)aoff, lb = (unsigned)boff + 65536u; asm volatile("" : "+v"(la), "+v"(lb));
            asm volatile("" : "+v"(voffB[0]), "+v"(voffB[1]));
            if constexpr (GATHER) asm volatile("" : "+v"(vA[0][0]), "+v"(vA[0][1]), "+v"(vA[1][0]), "+v"(vA[1][1]));
            if constexpr (Epi::MID) { if (t == nt / 2) { int t2 = tid; asm volatile("" : "+v"(t2)); E.mid(acc, cur, wr, wc, t2 & 15, (t2 & 63) >> 4); } }
            const char* a1 = cA + (size_t)(t + 1) * kstep;
            const char* a2 = last ? nA : cA + (size_t)(t + 2) * kstep; const char* b2 = last ? nB : cB + (size_t)(t + 2) * kstep;
            const char* a3 = a2 + kstep; const char* b3 = b2 + kstep;
            PG_LDB(B0, 0, 0); PG_LDB(B1, 0, 1); PG_SCHED; PG_LDA(At, 0, 0); PG_STAGE_A(PG_SA(1, 1), a1, 1);
            if constexpr (GATHER) { if (last) {
#pragma unroll
                for (int _h = 0; _h < 2; ++_h)
#pragma unroll
                    for (int _i = 0; _i < 2; ++_i) vA[_h][_i] = vN[_h][_i]; } }
            PG_WAIT_V(8); PG_WAIT_L(0); PG_BAR; PG_MMA(0, 0, At, B0); PG_MMA(0, 1, At, B1); PG_BAR; PG_SCHED;
            PG_LDA(At, 0, 1); PG_STAGE(PG_SB(0, 0), b2, voffB); PG_STAGE(PG_SB(0, 1), b2 + hstep, voffB); PG_STAGE_A(PG_SA(0, 0), a2, 0);
            PG_WAIT_V(8); PG_WAIT_L(0); PG_BAR; PG_MMA(1, 0, At, B0); PG_MMA(1, 1, At, B1); PG_BAR; PG_SCHED;
            if constexpr (Epi::RSC) { if (last) { const float* rp = E.rsc() + cur.pm * BM + (wid & 3) * 64 + (tid & 63); __builtin_amdgcn_global_load_lds((const unsigned*)rp, (LAS unsigned*)(lds + RSC_OFF + wid * 256), 4, 0, 0); } }
            PG_LDB(B0, 1, 0); PG_LDB(B1, 1, 1); PG_SCHED; PG_LDA(At, 1, 0); PG_STAGE_A(PG_SA(0, 1), a2, 1);
            if constexpr (Epi::RSC) { if (last) PG_WAIT_V(9); else PG_WAIT_V(8); } else PG_WAIT_V(8);
            PG_WAIT_L(0); PG_BAR; PG_MMA(0, 0, At, B0); PG_MMA(0, 1, At, B1); PG_BAR; PG_SCHED;
            PG_LDA(At, 1, 1); PG_STAGE(PG_SB(1, 0), b3, voffB); PG_STAGE(PG_SB(1, 1), b3 + hstep, voffB); PG_STAGE_A(PG_SA(1, 0), a3, 0);
            PG_WAIT_V(8); PG_WAIT_L(0); PG_BAR; PG_MMA(1, 0, At, B0); PG_MMA(1, 1, At, B1); PG_BAR; PG_SCHED;
        }
        if (wr == 0) PG_BAR;
        { int t2 = tid; Unit cu2 = cur; asm volatile("" : "+v"(t2), "+s"(cu2.pm), "+s"(cu2.pn)); E(acc, cu2, wr, wc, t2 & 15, (t2 & 63) >> 4); }
        if (!has_next) break;
        PG_ACC_INIT(nxt);
        cur = nxt; cA = nA; cB = nB; ++ui;
        if (wr == 1) PG_BAR;
    }
    PG_WAIT_V(0);
    PG_BAR;
#undef PG_SA
#undef PG_SB
#undef PG_STAGE
#undef PG_LDA
#undef PG_LDB
#undef PG_MMA
#undef PG_LD16
#undef PG_CAT2
#undef PG_LO
#undef PG_HI
#undef PG_WAIT_V
#undef PG_WAIT_L
#undef PG_BAR
#undef PG_SCHED
#undef PG_AOFFS
#undef PG_ACC_INIT
#undef PG_STAGE_A
}
}

typedef f32x4 AccT[2][2][4][2];
__device__ __forceinline__ u32x2 pack8_fp8(const f32x4 a, const f32x4 b) { int w0 = 0, w1 = 0; w0 = __builtin_amdgcn_cvt_pk_fp8_f32(a[0], a[1], w0, false); w0 = __builtin_amdgcn_cvt_pk_fp8_f32(a[2], a[3], w0, true);
    w1 = __builtin_amdgcn_cvt_pk_fp8_f32(b[0], b[1], w1, false); w1 = __builtin_amdgcn_cvt_pk_fp8_f32(b[2], b[3], w1, true); return (u32x2){(unsigned)w0, (unsigned)w1}; }
__device__ __forceinline__ u32x4 pack8(const f32x4 a, const f32x4 b) { u32x4 w; w.x = pk2(a[0], a[1]); w.y = pk2(a[2], a[3]); w.z = pk2(b[0], b[1]); w.w = pk2(b[2], b[3]); return w; }
__device__ __forceinline__ void unpack8(const u32x4 w, f32x4& a, f32x4& b) { a = (f32x4){bflo2f(w.x), bfhi2f(w.x), bflo2f(w.y), bfhi2f(w.y)}; b = (f32x4){bflo2f(w.z), bfhi2f(w.z), bflo2f(w.w), bfhi2f(w.w)}; }

__device__ __forceinline__ f32x4 inv1pexp2(const f32x4 e) { f32x4 d;
#pragma unroll
    for (int j = 0; j < 4; ++j) d[j] = __builtin_amdgcn_exp2f(min1(e[j], 60.0f));
    d = d + 1.0f;
    const f32x2 dlo = __builtin_shufflevector(d, d, 0, 1), dhi = __builtin_shufflevector(d, d, 2, 3), p = dlo * dhi;
    const f32x2 r = (f32x2){fast_rcp(p[0]), fast_rcp(p[1])};
    const f32x2 ilo = r * dhi, ihi = r * dlo;
    return __builtin_shufflevector(ilo, ihi, 0, 1, 2, 3); }
__device__ __forceinline__ f32x4 gelu4(const f32x4 x) { const f32x4 x2 = x * x; const f32x4 c = x2 * -0.1029432404f + -2.3022081981f; return x * inv1pexp2(x * c); }
template <bool F8> struct EpiInT {
    static constexpr bool MID = false, INIT = false, RSC = false, PREP = true;
    static constexpr float ASC = F8 ? 1.0f / WSCALE : 1.0f;
    bf16 *UG, *VG, *Q, *KB, *VB; unsigned short* G8; const float *bgate, *qg, *kg; LAS float* PL;
    __device__ __forceinline__ void prep(int tid) const {
        for (int i = tid; i < 2 * D / 4; i += NTHREADS) *(LAS f32x4*)(PL + 4 * i) = *(const f32x4*)(bgate + 4 * i);
        if (tid < 16) *(LAS f32x4*)(PL + 2 * D + 4 * tid) = *(const f32x4*)(qg + 4 * tid);
        else if (tid < 32) *(LAS f32x4*)(PL + 2 * D + 4 * tid) = *(const f32x4*)(kg + 4 * (tid - 16));
    }
    __device__ __forceinline__ void operator()(const AccT& acc, const pg::Unit& u, int wr, int wc, int fr, int fq) const {
        const int row0 = u.pm * 256 + wr * 64 + fr, pn = u.pn + (F8 ? 4 : 0);
        if (pn < 4) {
            bf16* base = (pn < 2 ? UG : VG) + (pn & 1) * 256 + 64 * wc + 8 * fq;
#pragma unroll
            for (int ai = 0; ai < 2; ++ai)
#pragma unroll
                for (int m = 0; m < 4; ++m) { bf16* rowp = base + (size_t)(row0 + ai * 128 + m * 16) * AW;
#pragma unroll
                    for (int bj = 0; bj < 2; ++bj) __builtin_nontemporal_store(pack8(gelu4(acc[ai][bj][m][0]), gelu4(acc[ai][bj][m][1])), (u32x4*)(rowp + 32 * bj)); }
        } else if (pn < 7) {
            const bool isq = pn < 6, norm = isq || wc < 2;
            const LAS float* gp = PL + 2 * D + (isq ? 0 : 64); const float sc = isq ? 0.125f * 1.4426950408889634f : 1.0f;
            f32x4 gv[2][2];
#pragma unroll
            for (int bj = 0; bj < 2; ++bj)
#pragma unroll
                for (int n = 0; n < 2; ++n) gv[bj][n] = *(const LAS f32x4*)(gp + 32 * bj + 8 * fq + 4 * n) * sc;
            bf16* base; int ld;
            if (isq) { base = Q + (pn - 4) * 256 + 64 * wc + 8 * fq; ld = BW; }
            else if (wc < 2) { base = KB + 64 * wc + 8 * fq; ld = KVW; }
            else { base = VB + 64 * (wc - 2) + 8 * fq; ld = KVW; }
#pragma unroll
            for (int ai = 0; ai < 2; ++ai)
#pragma unroll
                for (int m = 0; m < 4; ++m) { bf16* rowp = base + (size_t)(row0 + ai * 128 + m * 16) * ld;
                    float ss = 0.f;
#pragma unroll
                    for (int bj = 0; bj < 2; ++bj)
#pragma unroll
                        for (int n = 0; n < 2; ++n) { const f32x4 x = acc[ai][bj][m][n] * ASC; ss += (x[0] * x[0] + x[1] * x[1]) + (x[2] * x[2] + x[3] * x[3]); }
                    ss += __shfl_xor(ss, 16); ss += __shfl_xor(ss, 32);
                    const float rstd = norm ? rsqrtf(ss * (1.0f / 64.0f) + EPS) : 1.0f;
#pragma unroll
                    for (int bj = 0; bj < 2; ++bj) { f32x4 v0 = acc[ai][bj][m][0] * ASC, v1 = acc[ai][bj][m][1] * ASC;
                        if (norm) { v0 = v0 * rstd * gv[bj][0]; v1 = v1 * rstd * gv[bj][1]; }
                        __builtin_nontemporal_store(pack8(v0, v1), (u32x4*)(rowp + 32 * bj)); } }
        } else {
            const int c0 = 128 * (pn - 7) + 32 * wc + 8 * fq;
            f32x4 ba[2], bb[2];
#pragma unroll
            for (int n = 0; n < 2; ++n) { ba[n] = *(const LAS f32x4*)(PL + c0 + 4 * n) * -1.4426950408889634f; bb[n] = *(const LAS f32x4*)(PL + D + c0 + 4 * n) * -1.4426950408889634f; }
#pragma unroll
            for (int ai = 0; ai < 2; ++ai)
#pragma unroll
                for (int m = 0; m < 4; ++m) { const size_t ro = (size_t)(row0 + ai * 128 + m * 16) * D + c0;
                    unsigned wd[4];
#pragma unroll
                    for (int n = 0; n < 2; ++n) { f32x4 ea = acc[ai][0][m][n] * (-1.4426950408889634f * ASC) + ba[n], eb = acc[ai][1][m][n] * (-1.4426950408889634f * ASC) + bb[n], da, db;
#pragma unroll
                        for (int j = 0; j < 4; ++j) { da[j] = __builtin_amdgcn_exp2f(min1(ea[j], 43.0f)); db[j] = __builtin_amdgcn_exp2f(min1(eb[j], 43.0f)); }
                        da = da + 1.0f; db = db + 1.0f;
                        const f32x4 p = da * db; f32x4 r;
#pragma unroll
                        for (int j = 0; j < 4; ++j) r[j] = fast_rcp(p[j]);
                        r = r * 255.0f;
                        const f32x4 qa = db * r + 0.5f; f32x4 qb = da * r + 0.5f;
#pragma unroll
                        for (int j = 0; j < 4; ++j) qb[j] = max1(qb[j], 1.0f);
#pragma unroll
                        for (int k = 0; k < 2; ++k) { unsigned w_ = 0u;
                            w_ = __builtin_amdgcn_cvt_pk_u8_f32(qa[2 * k], 0u, w_); w_ = __builtin_amdgcn_cvt_pk_u8_f32(qb[2 * k], 1u, w_);
                            w_ = __builtin_amdgcn_cvt_pk_u8_f32(qa[2 * k + 1], 2u, w_); w_ = __builtin_amdgcn_cvt_pk_u8_f32(qb[2 * k + 1], 3u, w_); wd[2 * n + k] = w_; } }
                    u32x4 w; w.x = wd[0]; w.y = wd[1]; w.z = wd[2]; w.w = wd[3];
                    __builtin_nontemporal_store(w, (u32x4*)(G8 + ro)); }
        }
    }
};
struct EpiProj {
    static constexpr bool MID = true, INIT = false, RSC = false, PREP = false;
    const unsigned short* G8; bf16* MG;
    __device__ __forceinline__ void mid(AccT& acc, const pg::Unit& u, int wr, int wc, int fr, int fq) const {
        unsigned off = (unsigned)((wr * 64 + fr) * D + 64 * wc + 8 * fq) * 2u; asm volatile("" : "+v"(off));
        const char* base = (const char*)G8 + ((size_t)u.pm * 256 * D + (size_t)u.pn * 256) * 2;
#pragma unroll
        for (int ai = 0; ai < 2; ++ai) {
#pragma unroll
            for (int m = 0; m < 4; ++m) {
#pragma unroll
                for (int bj = 0; bj < 2; ++bj) { const u32x4 w = *(const u32x4*)(base + (off + (unsigned)(((ai * 128 + m * 16) * D + 32 * bj) * 2)));
                    const unsigned ww[4] = {w.x, w.y, w.z, w.w}; f32x4 r0, r1;
#pragma unroll
                    for (int k = 0; k < 4; ++k) { const float qa0 = (float)(ww[k] & 0xffu), qb0 = (float)((ww[k] >> 8) & 0xffu), qa1 = (float)((ww[k] >> 16) & 0xffu), qb1 = (float)(ww[k] >> 24);
                        const float rr = fast_rcp(qb0 * qb1); const float v0 = qa0 * (rr * qb1), v1 = qa1 * (rr * qb0);
                        if (k < 2) { r0[2 * k] = v0; r0[2 * k + 1] = v1; } else { r1[2 * (k - 2)] = v0; r1[2 * (k - 2) + 1] = v1; } }
                    acc[ai][bj][m][0] *= r0; acc[ai][bj][m][1] *= r1; } }
        }
    }
    __device__ __forceinline__ void operator()(const AccT& acc, const pg::Unit& u, int wr, int wc, int fr, int fq) const {
        const int row0 = u.pm * 256 + wr * 64 + fr, col0 = u.pn * 256 + 64 * wc + 8 * fq;
#pragma unroll
        for (int ai = 0; ai < 2; ++ai)
#pragma unroll
            for (int m = 0; m < 4; ++m) { const size_t ro = (size_t)(row0 + ai * 128 + m * 16) * D + col0;
#pragma unroll
                for (int bj = 0; bj < 2; ++bj) { const u32x4 w = *(const u32x4*)(G8 + ro + 32 * bj); const unsigned ww[4] = {w.x, w.y, w.z, w.w}; f32x4 g0, g1;
#pragma unroll
                    for (int k = 0; k < 4; ++k) { const float b0 = (float)((ww[k] >> 8) & 0xffu) * (1.0f / 255.0f), b1 = (float)(ww[k] >> 24) * (1.0f / 255.0f);
                        if (k < 2) { g0[2 * k] = b0; g0[2 * k + 1] = b1; } else { g1[2 * (k - 2)] = b0; g1[2 * (k - 2) + 1] = b1; } }
                    *(u32x4*)(MG + ro + 32 * bj) = pack8(acc[ai][bj][m][0] * g0, acc[ai][bj][m][1] * g1); } }
    }
};
struct EpiOut {
    static constexpr bool MID = false, INIT = true, RSC = false, PREP = false;
    const bf16* H0; const float* IRS0; const float* IG1; bf16* X1B;
    __device__ __forceinline__ void init(AccT& acc, const pg::Unit& u, int wr, int wc, int fr, int fq) const {
        const int row0 = u.pm * 256 + wr * 64 + fr, col0 = u.pn * 256 + 64 * wc + 8 * fq;
        f32x4 ig[2][2];
#pragma unroll
        for (int bj = 0; bj < 2; ++bj)
#pragma unroll
            for (int n = 0; n < 2; ++n) ig[bj][n] = *(const f32x4*)(IG1 + col0 + 32 * bj + 4 * n);
#pragma unroll
        for (int ai = 0; ai < 2; ++ai)
#pragma unroll
            for (int m = 0; m < 4; ++m) { const int row = row0 + ai * 128 + m * 16; const size_t ro = (size_t)row * D + col0; const float ir = IRS0[row];
#pragma unroll
                for (int bj = 0; bj < 2; ++bj) { f32x4 a, b; unpack8(*(const u32x4*)(H0 + ro + 32 * bj), a, b); acc[ai][bj][m][0] = a * ir * ig[bj][0]; acc[ai][bj][m][1] = b * ir * ig[bj][1]; } }
    }
    __device__ __forceinline__ void operator()(const AccT& acc, const pg::Unit& u, int wr, int wc, int fr, int fq) const {
        const int row0 = u.pm * 256 + wr * 64 + fr, col0 = u.pn * 256 + 64 * wc + 8 * fq;
#pragma unroll
        for (int ai = 0; ai < 2; ++ai)
#pragma unroll
            for (int m = 0; m < 4; ++m) { const size_t ro = (size_t)(row0 + ai * 128 + m * 16) * D + col0;
#pragma unroll
                for (int bj = 0; bj < 2; ++bj) *(u32x4*)(X1B + ro + 32 * bj) = pack8(acc[ai][bj][m][0], acc[ai][bj][m][1]); }
    }
};
struct EpiGU {
    static constexpr bool MID = false, INIT = false, RSC = true, PREP = false;
    const float* RS; unsigned char* HID; const LAS float* RSL;
    __device__ __forceinline__ const float* rsc() const { return RS; }
    __device__ __forceinline__ void operator()(const AccT& acc, const pg::Unit& u, int wr, int wc, int fr, int fq) const {
        const int row0 = u.pm * 256 + wr * 64 + fr, col0 = u.pn * 128 + 32 * wc + 8 * fq;
#pragma unroll
        for (int ai = 0; ai < 2; ++ai)
#pragma unroll
            for (int m = 0; m < 4; ++m) { const int row = row0 + ai * 128 + m * 16; const float rs = RSL[wr * 64 + fr + ai * 128 + m * 16] * (1.0f / WSCALE), rs2 = rs * rs, nrl = rs * -1.4426950408889634f;
                f32x4 h[2];
#pragma unroll
                for (int n = 0; n < 2; ++n) { const f32x4 ag = acc[ai][0][m][n], au = acc[ai][1][m][n]; h[n] = (ag * au * rs2) * inv1pexp2(ag * nrl); }
                __builtin_nontemporal_store(pack8_fp8(h[0], h[1]), (u32x2*)(HID + (size_t)row * FF + col0)); }
    }
};
struct EpiDown {
    static constexpr bool MID = false, INIT = false, RSC = true, PREP = false;
    const float* GATEV; unsigned char* Y; const LAS float* RSL;
    __device__ __forceinline__ const float* rsc() const { return GATEV; }
    __device__ __forceinline__ void operator()(const AccT& acc, const pg::Unit& u, int wr, int wc, int fr, int fq) const {
        const int row0 = u.pm * 256 + wr * 64 + fr, col0 = u.pn * 256 + 64 * wc + 8 * fq;
#pragma unroll
        for (int ai = 0; ai < 2; ++ai)
#pragma unroll
            for (int m = 0; m < 4; ++m) { const int row = row0 + ai * 128 + m * 16; const float gt = RSL[wr * 64 + fr + ai * 128 + m * 16] * (YSCALE / WSCALE); unsigned char* yp = Y + (size_t)row * D + col0;
#pragma unroll
                for (int bj = 0; bj < 2; ++bj) *(u32x2*)(yp + 32 * bj) = pack8_fp8(acc[ai][bj][m][0] * gt, acc[ai][bj][m][1] * gt); }
    }
};

__device__ __forceinline__ float wave_sum(float v) {
#pragma unroll
    for (int o = 1; o < 64; o <<= 1) v += __shfl_xor(v, o);
    return v;
}
template <int MAPID> __device__ __forceinline__ int drow(int c) {
    if (MAPID == 0) { if (c < 1792) return 256 * (c >> 8) + inv_bf16(c & 255); if (c < 2816) { const int g = c - 1792; return 256 * (7 + (g >> 7)) + inv_pair(0, g & 127); } const int g = c - 2816; return 256 * (7 + (g >> 7)) + inv_pair(1, g & 127); }
    if (MAPID == 1) return 256 * (c >> 8) + inv_bf16(c & 255);
    if (MAPID == 2) return 256 * (c >> 8) + inv_f32(c & 255);
    if (MAPID == 5) return drow<0>(c + 1024) - 1024;
    if (MAPID == 3) return 256 * (c >> 7) + inv_pair(0, c & 127);
    return 256 * (c >> 7) + inv_pair(1, c & 127);
}
template <int MAPID> __device__ __forceinline__ void p0_item(const float* W, int ld, int nblk, bf16* WT, int Kd, int koff, LAS float* scr, int item, int lane) {
    const int kb = item / nblk, nb = item % nblk, k0 = 64 * kb, n0 = 32 * nb;
    float wv[32];
#pragma unroll
    for (int i = 0; i < 32; ++i) wv[i] = __builtin_nontemporal_load(W + (size_t)(k0 + 2 * i + (lane >> 5)) * ld + n0 + (lane & 31));
#pragma unroll
    for (int i = 0; i < 32; ++i) scr[(2 * i + (lane >> 5)) * 33 + (lane & 31)] = wv[i];
    asm volatile("s_waitcnt lgkmcnt(0)" ::: "memory");
    const int c = lane & 7;
#pragma unroll
    for (int j = 0; j < 4; ++j) { const int n = (lane >> 3) + 8 * j; const LAS float* s = scr + (8 * c) * 33 + n;
        u32x4 o; o.x = pk2(s[0 * 33], s[1 * 33]); o.y = pk2(s[2 * 33], s[3 * 33]); o.z = pk2(s[4 * 33], s[5 * 33]); o.w = pk2(s[6 * 33], s[7 * 33]);
        *(u32x4*)(WT + (size_t)drow<MAPID>(n0 + n) * Kd + koff + k0 + 8 * c) = o; }
    asm volatile("s_waitcnt lgkmcnt(0)" ::: "memory");
}
template <int MAPID> __device__ __forceinline__ void p0_item8(const float* W, int ld, int nblk, unsigned char* WT, int Kd, float scale, LAS float* scr, int item, int lane) {
    const int kb = item / nblk, nb = item % nblk, k0 = 64 * kb, n0 = 32 * nb;
    float wv[32];
#pragma unroll
    for (int i = 0; i < 32; ++i) wv[i] = __builtin_nontemporal_load(W + (size_t)(k0 + 2 * i + (lane >> 5)) * ld + n0 + (lane & 31));
#pragma unroll
    for (int i = 0; i < 32; ++i) scr[(2 * i + (lane >> 5)) * 33 + (lane & 31)] = wv[i] * scale;
    asm volatile("s_waitcnt lgkmcnt(0)" ::: "memory");
    const int c = lane & 7;
#pragma unroll
    for (int j = 0; j < 4; ++j) { const int n = (lane >> 3) + 8 * j; const LAS float* s = scr + (8 * c) * 33 + n;
        const f32x4 a = (f32x4){s[0 * 33], s[1 * 33], s[2 * 33], s[3 * 33]}, b = (f32x4){s[4 * 33], s[5 * 33], s[6 * 33], s[7 * 33]};
        __builtin_nontemporal_store(pack8_fp8(a, b), (u32x2*)(WT + (size_t)drow<MAPID>(n0 + n) * Kd + k0 + 8 * c)); }
    asm volatile("s_waitcnt lgkmcnt(0)" ::: "memory");
}
struct P0Args { float* IRS0; float* IG1; const float *x, *g1, *w_in, *wpa, *wpb, *wout, *wsp, *g2, *wr, *wg, *wu, *wd; bf16 *WIN, *WPROJ, *WOUT, *WSP, *WRH, *WRL; unsigned char *WGU, *WDN; bf16* H; unsigned char *WIN8, *H0F8; };
__device__ __forceinline__ void p0_prologue(LAS unsigned char* lds, const P0Args& a, int gw, int NGW, int wave, int lane, int gtid, int NGT) {
    LAS float* scr = (LAS float*)(lds + wave * 16384);
    constexpr int I_IN = 16 * 120, I_IN8 = 16 * 88, I_PA = 8 * 32, I_OUT = 16 * 32, I_G = 16 * 64, I_D = 32 * 32;
    constexpr int NITEMS = I_IN + I_IN8 + 2 * I_PA + I_OUT + NE * (2 * I_G + I_D);
#ifndef MK_P0W
#define MK_P0W 1
#define MK_P0H 1
#endif
    for (int rpw = 0; rpw < MK_P0W; ++rpw)
    for (int it = gw; it < NITEMS; it += NGW) {
        int r = it;
        if (r < I_IN) { p0_item<0>(a.w_in, INC, 120, a.WIN, D, 0, scr, r, lane); continue; } r -= I_IN;
        if (r < I_IN8) { p0_item8<5>(a.w_in + 1024, INC, 88, a.WIN8, D, WSCALE, scr, r, lane); continue; } r -= I_IN8;
        if (r < I_PA) { p0_item<1>(a.wpa, D, 32, a.WPROJ, D, 0, scr, r, lane); continue; } r -= I_PA;
        if (r < I_PA) { p0_item<1>(a.wpb, D, 32, a.WPROJ, D, 512, scr, r, lane); continue; } r -= I_PA;
        if (r < I_OUT) { p0_item<1>(a.wout, D, 32, a.WOUT, D, 0, scr, r, lane); continue; } r -= I_OUT;
        if (r < NE * I_G) { const int e = r / I_G; p0_item8<3>(a.wg + (size_t)e * D * FF, FF, 64, a.WGU + (size_t)e * 4096 * D, D, WSCALE, scr, r % I_G, lane); continue; } r -= NE * I_G;
        if (r < NE * I_G) { const int e = r / I_G; p0_item8<4>(a.wu + (size_t)e * D * FF, FF, 64, a.WGU + (size_t)e * 4096 * D, D, WSCALE, scr, r % I_G, lane); continue; } r -= NE * I_G;
        { const int e = r / I_D; p0_item8<1>(a.wd + (size_t)e * FF * D, D, 32, a.WDN + (size_t)e * D * FF, FF, WSCALE, scr, r % I_D, lane); }
    }
    for (int i = gtid; i < 8 * 128 * 128 / 4; i += NGT) { const f32x4 v = *(const f32x4*)(a.wsp + 4 * (size_t)i); u32x2 o; o.x = pk2(v[0], v[1]); o.y = pk2(v[2], v[3]); *(u32x2*)(a.WSP + 4 * (size_t)i) = o; }
    for (int i = gtid; i < D; i += NGT) a.IG1[i] = 1.0f / a.g1[i];
    for (int i = gtid; i < NE * D; i += NGT) { const int e = i >> 10, k = i & 1023; const float v = a.wr[k * NE + e]; const bf16 h = f2bf(v); a.WRH[i] = h; a.WRL[i] = f2bf(v - bf2f(h)); }
    for (int rph = 0; rph < MK_P0H; ++rph)
    for (int m0 = gw; m0 < T; m0 += 4 * NGW) {
        f32x4 v[4][4]; float ssum[4];
#pragma unroll
        for (int r = 0; r < 4; ++r) { const f32x4* xr = (const f32x4*)(a.x + (size_t)(m0 + r * NGW) * D) + lane;
#pragma unroll
            for (int j = 0; j < 4; ++j) v[r][j] = __builtin_nontemporal_load(xr + 64 * j); }
#pragma unroll
        for (int r = 0; r < 4; ++r) { float s_ = 0.f;
#pragma unroll
            for (int j = 0; j < 4; ++j) s_ += (v[r][j][0] * v[r][j][0] + v[r][j][1] * v[r][j][1]) + (v[r][j][2] * v[r][j][2] + v[r][j][3] * v[r][j][3]);
            ssum[r] = wave_sum(s_); }
#pragma unroll
        for (int r = 0; r < 4; ++r) { const float rstd = rsqrtf(ssum[r] * (1.0f / D) + EPS); if (lane == 0) a.IRS0[m0 + r * NGW] = 1.0f / rstd; u32x2* o8 = (u32x2*)(a.H + (size_t)(m0 + r * NGW) * D) + lane;
#pragma unroll
            for (int j = 0; j < 4; ++j) { const f32x4 gg = *((const f32x4*)a.g1 + lane + 64 * j); const f32x4 y = v[r][j] * rstd * gg; u32x2 o; o.x = pk2(y[0], y[1]); o.y = pk2(y[2], y[3]); o8[64 * j] = o;
                int w8 = 0; w8 = __builtin_amdgcn_cvt_pk_fp8_f32(y[0], y[1], w8, false); w8 = __builtin_amdgcn_cvt_pk_fp8_f32(y[2], y[3], w8, true);
                ((unsigned*)(a.H0F8 + (size_t)(m0 + r * NGW) * D))[lane + 64 * j] = (unsigned)w8; } }
    }
}

__device__ __forceinline__ bf16x8 tr_pair(const LAS unsigned char* p0, const LAS unsigned char* p1) {
    const s16x4 a = __builtin_bit_cast(s16x4, __builtin_amdgcn_ds_read_tr16_b64_v4i16((LAS s16x4*)p0));
    const s16x4 b = __builtin_bit_cast(s16x4, __builtin_amdgcn_ds_read_tr16_b64_v4i16((LAS s16x4*)p1));
    return (bf16x8){a[0], a[1], a[2], a[3], b[0], b[1], b[2], b[3]};
}
constexpr int SP_STRIDE = 144, SP_IMG = 128 * SP_STRIDE, SP_PART = 8 * SP_IMG, SP_RSTD = SP_PART + 8 * 128 * 4, SP_END = SP_RSTD + 512;
__device__ __forceinline__ void spatial_unit(LAS unsigned char* lds, int bc, const bf16* UG, const bf16* VG, const float* vng, const bf16* WSP, const float* bsp, bf16* AO, int wave, int lane, int tid) {
    const int g = wave; const size_t row0 = (size_t)bc * 128;
    LAS unsigned char* img = lds + wave * SP_IMG; LAS float* part = (LAS float*)(lds + SP_PART); LAS float* rstd = (LAS float*)(lds + SP_RSTD);
    const int c8 = lane & 7, qr = lane >> 3;
    u32x4 v[16];
#pragma unroll
    for (int it = 0; it < 16; ++it) v[it] = *(const u32x4*)(VG + (row0 + 8 * it + qr) * AW + g * 64 + c8 * 8);
    const f32x4 g0 = *(const f32x4*)(vng + g * 64 + c8 * 8), g1 = *(const f32x4*)(vng + g * 64 + c8 * 8 + 4);
#pragma unroll
    for (int it = 0; it < 16; ++it) { f32x4 a, b; unpack8(v[it], a, b); float s = (a[0] * a[0] + a[1] * a[1]) + (a[2] * a[2] + a[3] * a[3]) + (b[0] * b[0] + b[1] * b[1]) + (b[2] * b[2] + b[3] * b[3]);
        s += __shfl_xor(s, 1); s += __shfl_xor(s, 2); s += __shfl_xor(s, 4); if (c8 == 0) part[g * 128 + 8 * it + qr] = s; }
    __syncthreads();
    if (tid < 128) { float t = 0.f;
#pragma unroll
        for (int w = 0; w < 8; ++w) t += part[w * 128 + tid];
        rstd[tid] = rsqrtf(t * (1.0f / AW) + EPS); }
    __syncthreads();
#pragma unroll
    for (int it = 0; it < 16; ++it) { const int q = 8 * it + qr; const float r = rstd[q]; f32x4 a, b; unpack8(v[it], a, b); *(LAS u32x4*)(img + q * SP_STRIDE + c8 * 16) = pack8(a * r * g0, b * r * g1); }
    asm volatile("s_waitcnt lgkmcnt(0)" ::: "memory");
    const int fr = lane & 15, fq = lane >> 4, qq = (lane & 15) >> 2, p4 = lane & 3;
    const bf16* wg = WSP + (size_t)g * 128 * 128;
#pragma unroll 1
    for (int nh = 0; nh < 2; ++nh) {
        f32x4 acc[4][4];
        u32x4 uu[4][2]; float bsv[4];
#pragma unroll
        for (int nb = 0; nb < 4; ++nb) { const int p = 64 * nh + 16 * nb + fr; const size_t ro = (row0 + p); bsv[nb] = bsp[g * 128 + p];
            uu[nb][0] = *(const u32x4*)(UG + ro * AW + g * 64 + 16 * fq); uu[nb][1] = *(const u32x4*)(UG + ro * AW + g * 64 + 16 * fq + 8); }
#pragma unroll
        for (int mb = 0; mb < 4; ++mb)
#pragma unroll
            for (int nb = 0; nb < 4; ++nb) acc[mb][nb] = (f32x4){0.f, 0.f, 0.f, 0.f};
#pragma unroll
        for (int kb = 0; kb < 4; ++kb) {
            bf16x8 af[4];
#pragma unroll
            for (int mb = 0; mb < 4; ++mb) { const LAS unsigned char* p = img + (32 * kb + 8 * fq + qq) * SP_STRIDE + (16 * p4 + 4 * mb) * 2; af[mb] = tr_pair(p, p + 4 * SP_STRIDE); }
#pragma unroll
            for (int nb = 0; nb < 4; ++nb) { const bf16x8 bfr = *(const bf16x8*)(wg + (size_t)(64 * nh + 16 * nb + fr) * 128 + 32 * kb + 8 * fq);
#pragma unroll
                for (int mb = 0; mb < 4; ++mb) acc[mb][nb] = __builtin_amdgcn_mfma_f32_16x16x32_bf16(af[mb], bfr, acc[mb][nb], 0, 0, 0); }
        }
#pragma unroll
        for (int nb = 0; nb < 4; ++nb) { const int p = 64 * nh + 16 * nb + fr; const float bs = bsv[nb]; const size_t ro = (row0 + p);
            const u32x4 u0 = uu[nb][0], u1 = uu[nb][1];
            f32x4 ua, ub, uc, ud; unpack8(u0, ua, ub); unpack8(u1, uc, ud);
            *(u32x4*)(AO + ro * D + g * 64 + 16 * fq) = pack8(ua * (acc[0][nb] + bs), ub * (acc[1][nb] + bs));
            *(u32x4*)(AO + ro * D + g * 64 + 16 * fq + 8) = pack8(uc * (acc[2][nb] + bs), ud * (acc[3][nb] + bs)); }
    }
    __syncthreads();
}
constexpr int AT_KSTR = 144, AT_VSTR = 160, AT_ROWS = 400, AT_K = 0, AT_V = AT_ROWS * AT_KSTR, AT_BIAS = AT_V + AT_ROWS * AT_VSTR, AT_BIASN = 304, AT_END = AT_BIAS + 8 * AT_BIASN * 4;
#define AT_LOAD_KV(bn_, kvh_) do { const int b_ = (bn_) >> 4, n_ = (bn_) & 15; _Pragma("unroll") for (int it = 0; it < 7; ++it) { const int c = tid + it * NTHREADS, s_ = c >> 3, ch = c & 7, pos = n_ * 128 - 128 + s_; \
        kv[it] = (u32x4){0u, 0u, 0u, 0u}; vv[it] = (u32x4){0u, 0u, 0u, 0u}; \
        if (s_ < 384 && pos >= 0 && pos < S) { const size_t ro = ((size_t)b_ * S + pos) * KVW + (kvh_) * 64 + ch * 8; kv[it] = *(const u32x4*)(KB + ro); vv[it] = *(const u32x4*)(VB + ro); } } } while (0)
#define AT_QBLOCK(EDGE_) do { \
            const int i0 = 64 * qh + 16 * qb, jb0 = 4 * qh + qb; const size_t qrow = brow + n * 128 + i0 + fr; \
            const bf16x8 q0 = qn0, q1 = qn1; \
            { const bf16* qx = qp + (size_t)((qb + 1) & 3) * 16 * BW; qn0 = *(const bf16x8*)qx; qn1 = *(const bf16x8*)(qx + 32); } \
            f32x4 sc[18]; float sum = 0.f; const LAS float* bl = bh + 16 + 4 * fq - fr; \
_Pragma("unroll") \
            for (int jbi = 0; jbi < 17; ++jbi) { const LAS unsigned char* kp = lds + AT_K + (16 * (jb0 + jbi) + fr) * AT_KSTR + 16 * fq; \
                const bf16x8 k0 = *(const LAS bf16x8*)kp, k1 = *(const LAS bf16x8*)(kp + 64); \
                f32x4 z = (f32x4){bl[16 * jbi], bl[16 * jbi + 1], bl[16 * jbi + 2], bl[16 * jbi + 3]}; \
                z = __builtin_amdgcn_mfma_f32_16x16x32_bf16(k0, q0, z, 0, 0, 0); z = __builtin_amdgcn_mfma_f32_16x16x32_bf16(k1, q1, z, 0, 0, 0); \
_Pragma("unroll") \
                for (int r = 0; r < 4; ++r) { const int xr = 16 * jbi + 4 * fq + r - fr; float p = __builtin_amdgcn_exp2f(z[r]); \
                    if (jbi == 0) p = (xr >= 0) ? p : 0.f; \
                    if (jbi == 16) p = (xr <= 256) ? p : 0.f; \
                    if (EDGE_) { const int pos = n * 128 - 128 + 16 * (jb0 + jbi) + 4 * fq + r; p = (pos >= 0 && pos < S) ? p : 0.f; } \
                    z[r] = p; sum += p; } \
                sc[jbi] = z; } \
            sc[17] = (f32x4){0.f, 0.f, 0.f, 0.f}; \
            sum += __shfl_xor(sum, 16); sum += __shfl_xor(sum, 32); \
            const float inv = fast_rcp(sum + __builtin_amdgcn_exp2f(snk * 1.4426950408889634f)); \
            f32x4 o[4]; \
_Pragma("unroll") \
            for (int mb = 0; mb < 4; ++mb) o[mb] = (f32x4){0.f, 0.f, 0.f, 0.f}; \
_Pragma("unroll") \
            for (int c = 0; c < 9; ++c) { const u32x4 pw = pack8(sc[2 * c], sc[2 * c + 1]); const bf16x8 pf = __builtin_bit_cast(bf16x8, pw); \
                const LAS unsigned char* vp = lds + AT_V + (16 * (jb0 + 2 * c) + 4 * fq + qq) * AT_VSTR + 8 * p4; \
_Pragma("unroll") \
                for (int mb = 0; mb < 4; ++mb) { const bf16x8 vf = tr_pair(vp + 32 * mb, vp + 32 * mb + 16 * AT_VSTR); o[mb] = __builtin_amdgcn_mfma_f32_16x16x32_bf16(vf, pf, o[mb], 0, 0, 0); } } \
            bf16* op = AO + qrow * D + 512 + h * 64 + 4 * fq; \
_Pragma("unroll") \
            for (int mb = 0; mb < 4; ++mb) { const f32x4 ov = o[mb] * inv; u32x2 w; w.x = pk2(ov[0], ov[1]); w.y = pk2(ov[2], ov[3]); *(u32x2*)(op + 16 * mb) = w; } \
        } while (0)
#define AT_QPTR(bn_, kvh_) (Q + ((size_t)((bn_) >> 4) * S + ((bn_) & 15) * 128 + 64 * (wave >> 2) + fr) * BW + (4 * (kvh_) + (wave & 3)) * 64 + 8 * fq)
__device__ __forceinline__ void attn_units(LAS unsigned char* lds, int bid, int G, const bf16* Q, const bf16* KB, const bf16* VB, const float* sink, const float* relt, bf16* AO, int wave, int lane, int tid) {
    const LAS float* bias = (const LAS float*)(lds + AT_BIAS);
    const int fr = lane & 15, fq = lane >> 4, qq = (lane & 15) >> 2, p4 = lane & 3;
    const int nu = (NB * 16 - bid + G - 1) / G, npass = 2 * nu;
    u32x4 kv[7], vv[7]; bf16x8 nq0, nq1;
    if (npass > 0) { AT_LOAD_KV(bid, 0); const bf16* qp0 = AT_QPTR(bid, 0); nq0 = *(const bf16x8*)qp0; nq1 = *(const bf16x8*)(qp0 + 32); }
    for (int i = tid; i < 8 * AT_BIASN; i += NTHREADS) { const int h = i / AT_BIASN, xx = i % AT_BIASN, rel = xx - 16 - 128; ((LAS float*)(lds + AT_BIAS))[i] = (rel >= -128 && rel <= 128) ? relt[t5_bucket(rel) * 8 + h] * 1.4426950408889634f : 0.f; }
#pragma unroll 1
    for (int pp = 0; pp < npass; ++pp) {
        const int bn = bid + (pp >> 1) * G, kvh = pp & 1, b = bn >> 4, n = bn & 15; const size_t brow = (size_t)b * S;
        const int h = 4 * kvh + (wave & 3), qh = wave >> 2; const float snk = sink[h];
        const bf16* qp = Q + (brow + n * 128 + 64 * qh + fr) * BW + h * 64 + 8 * fq;
        bf16x8 qn0 = nq0, qn1 = nq1;
        __syncthreads();
#pragma unroll
        for (int it = 0; it < 7; ++it) { const int c = tid + it * NTHREADS, s_ = c >> 3, ch = c & 7;
            if (c < AT_ROWS * 8) { *(LAS u32x4*)(lds + AT_K + s_ * AT_KSTR + ch * 16) = kv[it]; *(LAS u32x4*)(lds + AT_V + s_ * AT_VSTR + ch * 16) = vv[it]; } }
        __syncthreads();
        if (pp + 1 < npass) { AT_LOAD_KV(bid + ((pp + 1) >> 1) * G, (pp + 1) & 1); const bf16* qpn = AT_QPTR(bid + ((pp + 1) >> 1) * G, (pp + 1) & 1); nq0 = *(const bf16x8*)qpn; nq1 = *(const bf16x8*)(qpn + 32); }
        const bool edge = (n == 0) || (n == 15);
        const LAS float* bh = bias + h * AT_BIASN;
#pragma unroll 1
        for (int qb = 0; qb < 4; ++qb) { if (edge) { AT_QBLOCK(true); } else { AT_QBLOCK(false); } }
    }
}
#undef AT_LOAD_KV
#undef AT_QPTR
#undef AT_QBLOCK
__device__ __forceinline__ void p2_mixers(LAS unsigned char* lds, int bid, int G, const bf16* UG, const bf16* VG, const float* vng, const bf16* WSP, const float* bsp,
                                          const bf16* Q, const bf16* KB, const bf16* VB, const float* sink, const float* relt, bf16* AO, int wave, int lane, int tid) {
    for (int u = bid; u < NB * 16; u += G) spatial_unit(lds, u, UG, VG, vng, WSP, bsp, AO, wave, lane, tid);
    __syncthreads();
    attn_units(lds, bid, G, Q, KB, VB, sink, relt, AO, wave, lane, tid);
}

constexpr int P5_WSTR = 2 * D + 16, P5_WL = 16 * P5_WSTR, P5_G = 2 * P5_WL;
__device__ __forceinline__ void p5_router(LAS unsigned char* lds, const bf16* x1, const float* g2, const bf16* WRH, const bf16* WRL, unsigned char* H8, float* AFF, float* RSTD, int gw, int NGW, int lane, int tid) {
    const int fr = lane & 15, fq = lane >> 4;
    u32x4 xw[32];
    if (gw < T / 16) {
#pragma unroll
        for (int kb = 0; kb < 32; ++kb) xw[kb] = *(const u32x4*)(x1 + ((size_t)gw * 16 + fr) * D + 8 * fq + 32 * kb);
    }
    asm volatile("" ::: "memory");
    for (int i = tid; i < 16 * (D / 8); i += NTHREADS) { const int e = i >> 7, c = i & 127;
        *(LAS u32x4*)(lds + e * P5_WSTR + c * 16) = *(const u32x4*)(WRH + e * D + c * 8); *(LAS u32x4*)(lds + P5_WL + e * P5_WSTR + c * 16) = *(const u32x4*)(WRL + e * D + c * 8); }
    for (int i = tid; i < D / 4; i += NTHREADS) *(LAS f32x4*)(lds + P5_G + i * 16) = *(const f32x4*)(g2 + 4 * i);
    __syncthreads();
    const LAS unsigned char* whp = lds + fr * P5_WSTR + 16 * fq; const LAS unsigned char* gp = lds + P5_G + 32 * fq;
    for (int rb = gw; rb < T / 16; rb += NGW) {
        const size_t row = (size_t)rb * 16 + fr; const bf16* xr = x1 + row * D + 8 * fq; unsigned char* hr = H8 + row * D + 8 * fq;
        f32x4 acc = (f32x4){0.f, 0.f, 0.f, 0.f}; float ss = 0.f;
        if (rb != gw) {
#pragma unroll
            for (int kb = 0; kb < 32; ++kb) xw[kb] = *(const u32x4*)(xr + 32 * kb);
            asm volatile("" ::: "memory");
        }
#pragma unroll
        for (int kb = 0; kb < 32; ++kb) {
            f32x4 a0, a1; unpack8(xw[kb], a0, a1);
            const f32x4 ga = *(const LAS f32x4*)(gp + 128 * kb), gb = *(const LAS f32x4*)(gp + 128 * kb + 16);
            ss += (a0[0] * a0[0] + a0[1] * a0[1]) + (a0[2] * a0[2] + a0[3] * a0[3]) + (a1[0] * a1[0] + a1[1] * a1[1]) + (a1[2] * a1[2] + a1[3] * a1[3]);
            const f32x4 y0 = a0 * ga, y1 = a1 * gb;
            const u32x4 hw = pack8(y0, y1); f32x4 h0, h1; unpack8(hw, h0, h1);
            const u32x4 lw = pack8(y0 - h0, y1 - h1);
            *(u32x2*)(hr + 32 * kb) = pack8_fp8(y0, y1);
            const bf16x8 wh = *(const LAS bf16x8*)(whp + 64 * kb), wl = *(const LAS bf16x8*)(whp + P5_WL + 64 * kb);
            const bf16x8 xh = __builtin_bit_cast(bf16x8, hw), xl = __builtin_bit_cast(bf16x8, lw);
            acc = __builtin_amdgcn_mfma_f32_16x16x32_bf16(wh, xh, acc, 0, 0, 0);
            acc = __builtin_amdgcn_mfma_f32_16x16x32_bf16(wh, xl, acc, 0, 0, 0);
            acc = __builtin_amdgcn_mfma_f32_16x16x32_bf16(wl, xh, acc, 0, 0, 0);
        }
        ss += __shfl_xor(ss, 16); ss += __shfl_xor(ss, 32);
        const float rstd = rsqrtf(ss * (1.0f / D) + EPS);
        f32x4 lg = acc * rstd; float mx = fmaxf(fmaxf(lg[0], lg[1]), fmaxf(lg[2], lg[3]));
        mx = fmaxf(mx, __shfl_xor(mx, 16)); mx = fmaxf(mx, __shfl_xor(mx, 32));
        f32x4 e; float sum = 0.f;
#pragma unroll
        for (int r = 0; r < 4; ++r) { e[r] = expf(lg[r] - mx); sum += e[r]; }
        sum += __shfl_xor(sum, 16); sum += __shfl_xor(sum, 32);
        *(f32x4*)(AFF + row * NE + 4 * fq) = e * (1.0f / sum);
        if (fq == 0) RSTD[row] = rstd;
    }
}

__device__ __forceinline__ void p6_topk_item(LAS unsigned char* lds, int item, const float* AFF, const float* RSTD, int* IDX, float* GATEV, float* RS, short* INV, int wave, int lane, int tid) {
    LAS unsigned* hist = (LAS unsigned*)lds; LAS unsigned* sel = hist + 256; LAS unsigned* wtot = hist + 272;
    const int e = item >> 5, b = item & 31;
    unsigned key[4]; float val[4];
    const f32x4 rs4 = *(const f32x4*)(RSTD + (size_t)b * S + 4 * tid);
#pragma unroll
    for (int j = 0; j < 4; ++j) { val[j] = AFF[((size_t)b * S + 4 * tid + j) * NE + e]; key[j] = __float_as_uint(val[j]); }
    unsigned prefix = 0u, krem = CAP;
#pragma unroll 1
    for (int pass = 0; pass < 4; ++pass) {
        const int shift = 24 - 8 * pass;
        if (tid < 256) hist[tid] = 0u;
        __syncthreads();
#pragma unroll
        for (int j = 0; j < 4; ++j) if (pass == 0 || (key[j] >> (shift + 8)) == prefix) __hip_atomic_fetch_add(&hist[(key[j] >> shift) & 255u], 1u, __ATOMIC_RELAXED, __HIP_MEMORY_SCOPE_WORKGROUP);
        __syncthreads();
        if (wave == 0) {
            unsigned c[4];
#pragma unroll
            for (int j = 0; j < 4; ++j) c[j] = hist[4 * lane + j];
            const unsigned tot = c[0] + c[1] + c[2] + c[3]; unsigned sfx = tot;
#pragma unroll
            for (int o = 1; o < 64; o <<= 1) { const unsigned t = __shfl_down(sfx, o); if (lane + o < 64) sfx += t; }
            unsigned cum = sfx - tot;
#pragma unroll
            for (int j = 3; j >= 0; --j) { if (cum < krem && krem <= cum + c[j]) { sel[0] = 4u * lane + j; sel[1] = krem - cum; } cum += c[j]; }
        }
        __syncthreads();
        prefix = (prefix << 8) | sel[0]; krem = sel[1];
    }
    unsigned ngt = 0u, neq = 0u;
#pragma unroll
    for (int j = 0; j < 4; ++j) { ngt += key[j] > prefix; neq += key[j] == prefix; }
    unsigned pk = ngt | (neq << 16), inc = pk;
#pragma unroll
    for (int o = 1; o < 64; o <<= 1) { const unsigned t = __shfl_up(inc, o); if (lane >= o) inc += t; }
    if (lane == 63) wtot[wave] = inc;
    __syncthreads();
    unsigned base = inc - pk;
    for (int w = 0; w < wave; ++w) base += wtot[w];
    unsigned gi = base & 0xffffu, ei = base >> 16; const unsigned ngt_tot = CAP - krem;
#pragma unroll
    for (int j = 0; j < 4; ++j) { int slot = -1;
        if (key[j] > prefix) slot = (int)gi++; else if (key[j] == prefix) { if (ei < krem) slot = (int)(ngt_tot + ei); ++ei; }
        const int tok = b * S + 4 * tid + j; INV[(size_t)tok * NE + e] = (short)slot;
        if (slot >= 0) { const size_t r = (size_t)item * CAP + slot; IDX[r] = tok; GATEV[r] = val[j]; RS[r] = rs4[j]; } }
    __syncthreads();
}

__device__ __forceinline__ void p9_combine(const short* INV, const unsigned char* Y, const bf16* X1B, float* out, int gw, int NGW, int lane) {
    for (int t0 = gw; t0 < T; t0 += 2 * NGW) {
        f32x4 v[2][4]; int myslot[2]; unsigned long long mask[2];
#pragma unroll
        for (int r = 0; r < 2; ++r) { const int t = t0 + r * NGW; const u32x2* xp = (const u32x2*)(X1B + (size_t)t * D) + lane;
#pragma unroll
            for (int j = 0; j < 4; ++j) { const u32x2 w = __builtin_nontemporal_load(xp + 64 * j); v[r][j] = (f32x4){bflo2f(w.x), bfhi2f(w.x), bflo2f(w.y), bfhi2f(w.y)}; }
            myslot[r] = (lane < NE) ? (int)INV[(size_t)t * NE + lane] : -1; }
#pragma unroll
        for (int r = 0; r < 2; ++r) mask[r] = __ballot(myslot[r] >= 0);
        while (mask[0] | mask[1]) {
            unsigned w[2][2][4]; bool has[2][2];
#pragma unroll
            for (int r = 0; r < 2; ++r)
#pragma unroll
                for (int q = 0; q < 2; ++q) { has[r][q] = mask[r] != 0ull;
                    if (has[r][q]) { const int e = __builtin_ctzll(mask[r]); mask[r] &= mask[r] - 1; const int slot = __shfl(myslot[r], e); const int b = (t0 + r * NGW) >> 11;
                        const unsigned* yp = (const unsigned*)(Y + ((size_t)(e * NB + b) * CAP + slot) * D) + lane;
#pragma unroll
                        for (int j = 0; j < 4; ++j) w[r][q][j] = __builtin_nontemporal_load(yp + 64 * j); } }
#pragma unroll
            for (int r = 0; r < 2; ++r)
#pragma unroll
                for (int q = 0; q < 2; ++q) if (has[r][q]) {
#pragma unroll
                    for (int j = 0; j < 4; ++j) { const f32x2 lo = __builtin_amdgcn_cvt_pk_f32_fp8((int)w[r][q][j], false), hi = __builtin_amdgcn_cvt_pk_f32_fp8((int)w[r][q][j], true);
                        v[r][j] += (f32x4){lo[0], lo[1], hi[0], hi[1]} * (1.0f / YSCALE); } }
        }
#pragma unroll
        for (int r = 0; r < 2; ++r) { f32x4* op = (f32x4*)(out + (size_t)(t0 + r * NGW) * D) + lane;
#pragma unroll
            for (int j = 0; j < 4; ++j) __builtin_nontemporal_store(v[r][j], op + 64 * j); }
    }
}

constexpr int LDS_CTL_OFF = 155648, LDS_BYTES = LDS_CTL_OFF + 256;
static_assert(SP_END <= LDS_CTL_OFF && AT_END <= LDS_CTL_OFF && pg::LTAB_OFF + pg::LTAB_BYTES <= LDS_CTL_OFF && LDS_BYTES <= 163840, "LDS map");
constexpr int NPHASE = 10;
#ifndef MK_REV8
#define MK_REV8 1
#endif
#ifndef MK_WGM7
#define MK_WGM7 4
#define MK_WGM8 4
#endif
#ifndef MK_REPEAT
#define MK_REPEAT -1
#endif
struct Args { const float* in[19]; float* out; unsigned char* ws; int ph_lo, ph_hi, li, pad; };
typedef const Args __attribute__((address_space(4))) CArgs;
__global__ void __launch_bounds__(NTHREADS, 2) mk_fwd(Args) {
    extern __shared__ __attribute__((aligned(16))) unsigned char lds_raw[];
    LAS unsigned char* lds = (LAS unsigned char*)lds_raw;
    CArgs* ap0 = (CArgs*)__builtin_amdgcn_kernarg_segment_ptr();
    const int tid = threadIdx.x, lane = tid & 63, wave = __builtin_amdgcn_readfirstlane(tid >> 6);
    const int G = gridDim.x, bid = blockIdx.x;
    const int gw = bid * NWAVES + wave, NGW = G * NWAVES, gtid = bid * NTHREADS + tid, NGT = G * NTHREADS;
    if (tid < 64) ((LAS unsigned*)(lds + LDS_CTL_OFF))[tid] = 0u;
    __syncthreads();
    const int lo = ap0->ph_lo, hi = ap0->ph_hi;
    XcdBarrier bar = xcd_barrier_post((unsigned*)(ap0->ws + WS_CTL) + CW_BAR + ap0->li * XCD_BAR_WORDS, (volatile LAS unsigned*)(lds + LDS_CTL_OFF));
#define IN(k) (lo <= (k) && (k) < hi)
#define SEAM(k) do { if (IN(k) && IN((k) + 1)) xcd_barrier(bar); } while (0)
#define PH CArgs* ap = ap0; asm volatile("" : "+s"(ap)); unsigned char* const ws = ap->ws; (void)ws
#define WSP(T_, off) ((T_*)(ws + (off)))
#define DUP(k, ...) __VA_ARGS__

#define BODY0 { PH; P0Args a{WSP(float, WS_RSTD0), WSP(float, WS_IG1), ap->in[0], ap->in[1], ap->in[2], ap->in[11], ap->in[12], ap->in[13], ap->in[5], ap->in[14], ap->in[15], ap->in[16], ap->in[17], ap->in[18], WSP(bf16, WS_WIN), WSP(bf16, WS_WPROJ), WSP(bf16, WS_WOUT), \
        WSP(bf16, WS_WSP), WSP(bf16, WS_WRH), WSP(bf16, WS_WRL), ws + WS_WGU, ws + WS_WDN, WSP(bf16, WS_H), ws + WS_WIN8, ws + WS_H0F8}; p0_prologue(lds, a, gw, NGW, wave, lane, gtid, NGT); }
#define BODY1 { PH; { pg::Prob g{(const char*)(ws + WS_H), nullptr, (const char*)(ws + WS_WIN), D * 2, 31, 0}; pg::StaticOrder So; So.init(T, 1024, G, bid); \
        EpiInT<false> E{WSP(bf16, WS_UG), WSP(bf16, WS_VG), WSP(bf16, WS_Q), WSP(bf16, WS_K), WSP(bf16, WS_VB), WSP(unsigned short, WS_R), ap->in[3], ap->in[7], ap->in[8], (LAS float*)(lds + pg::LTAB_OFF)}; pg::gemm_phase<EpiInT<false>, false, false>(lds, g, So, E); } \
        { pg::Prob g{(const char*)(ws + WS_H0F8), nullptr, (const char*)(ws + WS_WIN8), D, 31, 0}; pg::StaticOrder So; So.init(T, 2816, G, bid); \
        EpiInT<true> E{WSP(bf16, WS_UG), WSP(bf16, WS_VG), WSP(bf16, WS_Q), WSP(bf16, WS_K), WSP(bf16, WS_VB), WSP(unsigned short, WS_R), ap->in[3], ap->in[7], ap->in[8], (LAS float*)(lds + pg::LTAB_OFF)}; pg::gemm_phase<EpiInT<true>, true, false>(lds, g, So, E); } }
#define BODY2 { PH; p2_mixers(lds, bid, G, WSP(bf16, WS_UG), WSP(bf16, WS_VG), ap->in[4], WSP(bf16, WS_WSP), ap->in[6], WSP(bf16, WS_Q), WSP(bf16, WS_K), WSP(bf16, WS_VB), ap->in[9], ap->in[10], WSP(bf16, WS_AO), wave, lane, tid); }
#define BODY3 { PH; pg::Prob g{(const char*)(ws + WS_AO), nullptr, (const char*)(ws + WS_WPROJ), D * 2, 31, 0}; pg::StaticOrder So; So.init(T, D, G, bid); \
        EpiProj E{WSP(unsigned short, WS_R), WSP(bf16, WS_MG)}; pg::gemm_phase<EpiProj, false, false>(lds, g, So, E); }
#define BODY4 { PH; pg::Prob g{(const char*)(ws + WS_MG), nullptr, (const char*)(ws + WS_WOUT), D * 2, 31, 0}; pg::StaticOrder So; So.init(T, D, G, bid); \
        EpiOut E{WSP(bf16, WS_H), WSP(float, WS_RSTD0), WSP(float, WS_IG1), WSP(bf16, WS_X1B)}; pg::gemm_phase<EpiOut, false, false>(lds, g, So, E); }
#define BODY5 { PH; p5_router(lds, WSP(bf16, WS_X1B), ap->in[14], WSP(bf16, WS_WRH), WSP(bf16, WS_WRL), ws + WS_H, WSP(float, WS_AFF), WSP(float, WS_RSTD), gw, NGW, lane, tid); __syncthreads(); }
#define BODY6 { PH; for (int it = bid; it < NE * NB; it += G) p6_topk_item(lds, it, WSP(float, WS_AFF), WSP(float, WS_RSTD), WSP(int, WS_IDX), WSP(float, WS_GATEV), WSP(float, WS_RS), WSP(short, WS_INV), wave, lane, tid); }
#define BODY7 { PH; pg::Prob g{(const char*)(ws + WS_H), WSP(int, WS_IDX), (const char*)(ws + WS_WGU), D, 5, (size_t)4096 * D}; pg::StaticOrder So; So.init(NSLOT, 4096, G, bid, MK_WGM7); \
        EpiGU E{WSP(float, WS_RS), ws + WS_HID, (const LAS float*)(lds + pg::RSC_OFF)}; pg::gemm_phase<EpiGU, true, true>(lds, g, So, E); }
#define BODY8 { PH; pg::Prob g{(const char*)(ws + WS_HID), nullptr, (const char*)(ws + WS_WDN), FF, 5, (size_t)D * FF}; pg::StaticOrder So; So.init(NSLOT, D, G, bid, MK_WGM8, MK_REV8); \
        EpiDown E{WSP(float, WS_GATEV), ws + WS_Y, (const LAS float*)(lds + pg::RSC_OFF)}; pg::gemm_phase<EpiDown, true, false>(lds, g, So, E); }
#define BODY9 { PH; int t9 = threadIdx.x; asm volatile("" : "+v"(t9)); p9_combine(WSP(short, WS_INV), ws + WS_Y, WSP(bf16, WS_X1B), ap->out, bid * NWAVES + __builtin_amdgcn_readfirstlane(t9 >> 6), NGW, t9 & 63); }
#define RUN(k, BODY) do { if (IN(k)) { BODY if (MK_REPEAT == (k)) { xcd_barrier(bar); BODY } } } while (0)
    RUN(0, BODY0); SEAM(0);
    RUN(1, BODY1);
    SEAM(1);
    RUN(2, BODY2); SEAM(2);
    RUN(3, BODY3); SEAM(3);
    RUN(4, BODY4); SEAM(4);
    RUN(5, BODY5); SEAM(5);
    RUN(6, BODY6); SEAM(6);
    RUN(7, BODY7);
    SEAM(7);
    RUN(8, BODY8); SEAM(8);
    if (IN(9)) BODY9
#undef IN
#undef SEAM
#undef PH
#undef WSP
#undef RUN
}

extern "C" void kernel_launch(void* const* d_in, const int* in_sizes, int n_in, void* d_out, int out_size, void* d_ws, size_t ws_size, hipStream_t stream) {
    static int grid = 0;
    if (grid == 0) {
        if (n_in != 19 || out_size != T * D || ws_size < WS_END) { fprintf(stderr, "kernel_launch: unexpected problem shape (n_in %d, out %d, ws %zu)\n", n_in, out_size, ws_size); grid = -1; return; }
        int dev = 0, cus = 0, per_cu = 0;
        if (hipGetDevice(&dev) != hipSuccess || hipDeviceGetAttribute(&cus, hipDeviceAttributeMultiprocessorCount, dev) != hipSuccess) { grid = -1; return; }
        if (hipFuncSetAttribute((const void*)mk_fwd, hipFuncAttributeMaxDynamicSharedMemorySize, LDS_BYTES) != hipSuccess) { fprintf(stderr, "kernel_launch: hipFuncSetAttribute failed\n"); grid = -1; return; }
        if (hipOccupancyMaxActiveBlocksPerMultiprocessor(&per_cu, (const void*)mk_fwd, NTHREADS, LDS_BYTES) != hipSuccess || per_cu < 1) fprintf(stderr, "kernel_launch: occupancy query reports %d\n", per_cu);
        (void)hipGetLastError();
        if (cus < 256) { fprintf(stderr, "kernel_launch: built for a 256-CU device (%d CUs found); nothing launched\n", cus); grid = -1; return; }
        grid = 256;
    }
    if (grid < 0) return;
    (void)hipMemsetAsync((char*)d_ws + WS_CTL, 0, CTL_ZERO_BYTES, stream);
    Args a{};
    for (int i = 0; i < 19; ++i) a.in[i] = (const float*)d_in[i];
    a.out = (float*)d_out; a.ws = (unsigned char*)d_ws;
    a.ph_lo = 0; a.ph_hi = NPHASE; a.li = 0; a.pad = 0;
    hipLaunchKernelGGL(mk_fwd, dim3(grid), dim3(NTHREADS), LDS_BYTES, stream, a);
}
```

```cpp
#include <hip/hip_runtime.h>
#include <stdint.h>
#include <stdio.h>

#define LAS __attribute__((address_space(3)))
#define GAS __attribute__((address_space(1)))
typedef unsigned short bf16;
typedef short bf16x8 __attribute__((ext_vector_type(8)));
typedef short s16x4 __attribute__((ext_vector_type(4)));
typedef float f32x4 __attribute__((ext_vector_type(4)));
typedef float f32x2 __attribute__((ext_vector_type(2)));
typedef unsigned u32x4 __attribute__((ext_vector_type(4)));
typedef unsigned u32x2 __attribute__((ext_vector_type(2)));

constexpr int NB = 32, S = 2048, D = 1024, T = NB * S;
constexpr int AW = 512, BW = 512, KVW = 128, INC = 3840, NE = 16, FF = 2048, CAP = 256, NSLOT = NE * NB * CAP;
constexpr float EPS = 1e-6f;
constexpr int NWAVES = 8, NTHREADS = 512;

constexpr size_t MiB = 1u << 20;
constexpr size_t WS_CTL = 0, CTL_ZERO_BYTES = 64 * 1024;
constexpr size_t WS_WIN = 1 * MiB, WS_WPROJ = 9 * MiB, WS_WOUT = 11 * MiB, WS_WSP = 13 * MiB, WS_WRH = 13 * MiB + 512 * 1024, WS_WRL = 13 * MiB + 768 * 1024;
constexpr size_t WS_WDN = 14 * MiB, WS_WGU = 46 * MiB;
constexpr size_t WS_H = 206 * MiB, WS_AFF = 334 * MiB, WS_IDX = 338 * MiB, WS_GATEV = 338 * MiB + 512 * 1024, WS_RS = 339 * MiB, WS_RSTD = 339 * MiB + 512 * 1024, WS_RSTD0 = 339 * MiB + 768 * 1024;
constexpr size_t WS_UG = 340 * MiB, WS_VG = 404 * MiB, WS_Q = 468 * MiB, WS_K = 532 * MiB, WS_VB = 548 * MiB, WS_R = 564 * MiB, WS_GB = 692 * MiB, WS_AO = 820 * MiB;
constexpr size_t WS_MG = 340 * MiB, WS_HID = 340 * MiB, WS_INV = 852 * MiB, WS_X1B = 856 * MiB, WS_END = 984 * MiB;
constexpr size_t WS_H0F8 = 692 * MiB, WS_WIN8 = 760 * MiB;
constexpr size_t WS_Y = 596 * MiB;
constexpr float YSCALE = 16.0f;
constexpr float WSCALE = 32.0f;
constexpr size_t WS_IG1 = 512 * 1024;
constexpr int CW_TMO = 0, CW_BAR = 4096;

__device__ __forceinline__ float bf2f(unsigned b) { return __uint_as_float((b & 0xffffu) << 16); }
__device__ __forceinline__ float bfhi2f(unsigned w) { return __uint_as_float(w & 0xffff0000u); }
__device__ __forceinline__ float bflo2f(unsigned w) { return __uint_as_float(w << 16); }
__device__ __forceinline__ bf16 f2bf(float f) { unsigned u = __float_as_uint(f); u += 0x7fffu + ((u >> 16) & 1u); return (bf16)(u >> 16); }
__device__ __forceinline__ unsigned pk2(float lo, float hi) { unsigned r; asm volatile("v_cvt_pk_bf16_f32 %0, %1, %2" : "=v"(r) : "v"(lo), "v"(hi)); return r; }
__device__ __forceinline__ int t5_bucket(int rel) { const int n = rel < 0 ? -rel : rel; const int v = n < 8 ? n : 8 + (n >= 12) + (n >= 16) + (n >= 23) + (n >= 32) + (n >= 46) + (n >= 64) + (n >= 91); return (rel > 0 ? 16 : 0) + v; }
__device__ __forceinline__ float fast_exp(float x) { return __builtin_amdgcn_exp2f(x * 1.4426950408889634f); }
__device__ __forceinline__ float fast_rcp(float x) { return __builtin_amdgcn_rcpf(x); }
__device__ __forceinline__ float min1(float a, float b) { float r; asm("v_min_f32 %0, %1, %2" : "=v"(r) : "v"(a), "v"(b)); return r; }
__device__ __forceinline__ float max1(float a, float b) { float r; asm("v_max_f32 %0, %1, %2" : "=v"(r) : "v"(a), "v"(b)); return r; }
__device__ __forceinline__ float clamp1(float x, float lo, float hi) { return __builtin_amdgcn_fmed3f(x, lo, hi); }
__device__ __forceinline__ float gelu_t(float x) { const float x2 = x * x; const float a = x * (-2.3022081981f - 0.1029432404f * x2); return x * fast_rcp(1.0f + __builtin_amdgcn_exp2f(a)); }

__device__ __forceinline__ int inv_bf16(int L) { return 128 * ((L >> 5) & 1) + 32 * (L >> 6) + 16 * ((L >> 2) & 1) + 4 * ((L >> 3) & 3) + (L & 3); }
__device__ __forceinline__ int inv_f32(int L) { return 128 * ((L >> 5) & 1) + 32 * (L >> 6) + 16 * ((L >> 4) & 1) + 4 * ((L >> 2) & 3) + (L & 3); }
__device__ __forceinline__ int inv_pair(int which, int L) { return 128 * which + 32 * (L >> 5) + 16 * ((L >> 2) & 1) + 4 * ((L >> 3) & 3) + (L & 3); }

#define XB_TMO      128
#define XB_XCNT(j)  (256  + 64 * (j))
#define XB_XSUB(j)  (1280 + 64 * (j))
#define XB_XGEN(j)  (2304 + 64 * (j))
#define XB_TOP      3328
#define XB_TOPGEN   3392
#define XCD_BAR_WORDS 3456
#define XB_SPIN_CAP (1u << 18)
__device__ __forceinline__ unsigned xb_ld(unsigned* p)              { return __hip_atomic_load(p, __ATOMIC_RELAXED, __HIP_MEMORY_SCOPE_AGENT); }
__device__ __forceinline__ unsigned xb_add(unsigned* p, unsigned v) { return __hip_atomic_fetch_add(p, v, __ATOMIC_RELAXED, __HIP_MEMORY_SCOPE_AGENT); }
__device__ __forceinline__ unsigned xb_xcc_id() { return (unsigned)__builtin_amdgcn_s_getreg((3 << 11) | 20) & 0xFu; }
#define XB_SPIN(cond, bar) do { unsigned _sp = 0; while (cond) { __builtin_amdgcn_s_sleep(1); \
    if ((++_sp & 255u) == 0u) { if (xb_ld(&(bar)[XB_TMO])) break; if (_sp > XB_SPIN_CAP) { atomicAdd(&(bar)[XB_TMO], 1u); break; } } } } while (0)
struct XcdBarrier { unsigned* bar; unsigned x; volatile LAS unsigned* st; };
__device__ __forceinline__ XcdBarrier xcd_barrier_post(unsigned* bar, volatile LAS unsigned* st) {
    XcdBarrier b; b.bar = bar; b.x = xb_xcc_id(); b.st = st;
    if (threadIdx.x == 0) (void)xb_add(&bar[XB_XCNT(b.x)], 1u);
    return b;
}
__device__ __forceinline__ void xcd_barrier_complete(unsigned* bar, unsigned x, unsigned& nloc, unsigned& nx) {
    const unsigned G = gridDim.x * gridDim.y * gridDim.z;
    unsigned sum, cnt, mine, sp = 0u;
    for (;;) {
        sum = 0u; cnt = 0u; mine = 0u;
#pragma unroll
        for (unsigned j = 0; j < 16; ++j) { const unsigned c = xb_ld(&bar[XB_XCNT(j)]); sum += c; cnt += (c > 0u) ? 1u : 0u; mine = (j == x) ? c : mine; }
        if (sum == G) break;
        __builtin_amdgcn_s_sleep(1);
        if ((++sp & 255u) == 0u) { if (xb_ld(&bar[XB_TMO])) break; if (sp > XB_SPIN_CAP) { atomicAdd(&bar[XB_TMO], 1u); break; } }
    }
    nloc = mine > 0u ? mine : 1u; nx = cnt > 0u ? cnt : 1u;
}
__device__ __forceinline__ void xcd_barrier(const XcdBarrier& b) {
    asm volatile("s_waitcnt vmcnt(0)" ::: "memory");
    __syncthreads();
    if (threadIdx.x == 0) {
        unsigned* bar = b.bar;
        __builtin_amdgcn_s_waitcnt(0);
        unsigned nloc = b.st[0], nx = b.st[1];
        if (nloc == 0u) { xcd_barrier_complete(bar, b.x, nloc, nx); b.st[0] = nloc; b.st[1] = nx; }
        const unsigned old = xb_add(&bar[XB_XSUB(b.x)], 1u);
        const unsigned gen = old / nloc;
        if (old + 1u == (gen + 1u) * nloc) {
            __builtin_amdgcn_fence(__ATOMIC_RELEASE, "agent");
            asm volatile("s_waitcnt vmcnt(0)" ::: "memory");
            const unsigned og = xb_add(&bar[XB_TOP], 1u);
            const unsigned tg = og / nx;
            if (og + 1u == (tg + 1u) * nx) xb_add(&bar[XB_TOPGEN], 1u);
            else XB_SPIN(xb_ld(&bar[XB_TOPGEN]) == tg, bar);
            __builtin_amdgcn_fence(__ATOMIC_ACQUIRE, "agent");
            xb_add(&bar[XB_XGEN(b.x)], 1u);
            asm volatile("s_waitcnt vmcnt(0)" ::: "memory");
        } else {
            XB_SPIN(xb_ld(&bar[XB_XGEN(b.x)]) == gen, bar);
            __builtin_amdgcn_fence(__ATOMIC_ACQUIRE, "agent");
            asm volatile("s_waitcnt vmcnt(0)" ::: "memory");
        }
    }
    __syncthreads();
}

namespace pg {
typedef int i32x4 __attribute__((ext_vector_type(4)));
typedef int i32x8 __attribute__((ext_vector_type(8)));
typedef double f64x2 __attribute__((ext_vector_type(2)));
constexpr int BM = 256, BK = 64, HALF = 128, HTB = HALF * BK * 2, STAGE_BYTES = 8 * HTB, NXCD = 8, WGM = 4;
__device__ __forceinline__ int lds_byte(int r, int c) { const int st = (r >> 4) * 2 + (c >> 5), rr = r & 15, cc = c & 31, ob = rr * 64 + cc * 2; return st * 1024 + (ob ^ (((ob >> 9) & 1) << 5)); }
__device__ __forceinline__ void stage_rc(int b, int& R, int& C) { const int st = b / 1024, sb = b % 1024, swz = sb ^ (((sb >> 9) & 1) << 5); R = (st >> 1) * 16 + swz / 64; C = (st & 1) * 32 + (swz % 64) / 2; }
struct Unit { int pm, pn; };
struct StaticOrder {
    int nM, nN, nwg, G, c, wgm, rev;
    __device__ __forceinline__ void init(int M, int N, int G_, int c_, int wgm_ = WGM, int rev_ = 0) { nM = M / BM; nN = N / BM; nwg = nM * nN; G = G_; c = c_; wgm = wgm_; rev = rev_; }
    __device__ __forceinline__ bool next(int i, Unit& u) const {
        const long L = (long)i * G + c; if (L >= nwg) return false;
        int wgid = (int)L; { const int q = nwg / NXCD, r = nwg % NXCD, xcd = wgid % NXCD, off = wgid / NXCD; wgid = (xcd < r ? xcd * (q + 1) : r * (q + 1) + (xcd - r) * q) + off; }
        const int nig = wgm * nN, gid = wgid / nig, fm = gid * wgm, gsz = (nM - fm) < wgm ? (nM - fm) : wgm;
        u.pm = fm + ((wgid % nig) % gsz); u.pn = (wgid % nig) / gsz; if (rev) u.pm = nM - 1 - u.pm; return true;
    }
};
struct Prob { const char* A; const int* idx; const char* Bt; int KB; int gshift; size_t gstride; };
constexpr int LTAB_OFF = STAGE_BYTES, LTAB_BYTES = 32 * 256 * 2, RSC_OFF = LTAB_OFF + LTAB_BYTES;

__device__ __forceinline__ const char* uni(const char* p) { const unsigned long long v = (unsigned long long)p; const unsigned lo = __builtin_amdgcn_readfirstlane((unsigned)v), hi = __builtin_amdgcn_readfirstlane((unsigned)(v >> 32)); return (const char*)(((unsigned long long)hi << 32) | lo); }
template <class Epi, bool FP8, bool GATHER, class Sched = StaticOrder>
__device__ __forceinline__ void gemm_phase(LAS unsigned char* lds, const Prob g, const Sched& S, const Epi& E) {
    const int tid = threadIdx.x, wid = __builtin_amdgcn_readfirstlane(tid >> 6), lane = tid & 63, wr = wid >> 2, wc = wid & 3, fr = lane & 15, fq = lane >> 4;
    const int KB = g.KB, nt = KB / (BK * 2);
    int R2[2], C2[2]; unsigned voffB[2];
#pragma unroll
    for (int i = 0; i < 2; ++i) { stage_rc(tid * 16 + i * 8192, R2[i], C2[i]); voffB[i] = (unsigned)(R2[i] * KB + C2[i] * 2); }
    const size_t kstep = (size_t)(BK * 2);
    const size_t hstep = (size_t)HALF * KB;
    const size_t tstep = 2 * hstep;
    const unsigned rowb = (unsigned)KB;
    const unsigned ldsw = (unsigned)wid * 1024u;
    const int aoff = lds_byte(wr * 64 + fr, fq * 8), boff = lds_byte(wc * 32 + fr, fq * 8);
#define PG_SA(b, h) (((b) * 2 + (h)) * HTB)
#define PG_SB(b, h) ((4 + (b) * 2 + (h)) * HTB)
#define PG_STAGE(bufoff, gbase, voff) do { _Pragma("unroll") for (int _i = 0; _i < 2; ++_i) \
        __builtin_amdgcn_global_load_lds((const unsigned*)(uni((const char*)(gbase)) + (voff)[_i]), (LAS unsigned*)(lds + (bufoff) + ldsw + _i * 8192), 16, 0, 0); } while (0)
#define PG_LD16(base, off) (*(const LAS i32x4*)(lds + (base) + (off)))
#define PG_CAT2(lo, hi) __builtin_shufflevector((lo), (hi), 0, 1, 2, 3, 4, 5, 6, 7)
#define PG_LDA(dst, b, h) do { _Pragma("unroll") for (int m = 0; m < 4; ++m) dst[m] = PG_CAT2(PG_LD16(la, PG_SA(b, h) + m * 2048), PG_LD16(la, PG_SA(b, h) + m * 2048 + 1024)); } while (0)
#define PG_LDB(dst, b, h) do { _Pragma("unroll") for (int n = 0; n < 2; ++n) dst[n] = PG_CAT2(PG_LD16(lb, PG_SB(b, h) - 65536 + n * 2048), PG_LD16(lb, PG_SB(b, h) - 65536 + n * 2048 + 1024)); } while (0)
#define PG_LO(x) __builtin_bit_cast(bf16x8, __builtin_shufflevector((x), (x), 0, 1, 2, 3))
#define PG_HI(x) __builtin_bit_cast(bf16x8, __builtin_shufflevector((x), (x), 4, 5, 6, 7))
#define PG_MMA(ai, bj, At, Bt) do { __builtin_amdgcn_s_setprio(1); _Pragma("unroll") for (int m = 0; m < 4; ++m) _Pragma("unroll") for (int n = 0; n < 2; ++n) { \
        if constexpr (FP8) acc[ai][bj][m][n] = __builtin_amdgcn_mfma_scale_f32_16x16x128_f8f6f4(Bt[n], At[m], acc[ai][bj][m][n], 0, 0, 0, 0, 0, 0); \
        else { acc[ai][bj][m][n] = __builtin_amdgcn_mfma_f32_16x16x32_bf16(PG_LO(Bt[n]), PG_LO(At[m]), acc[ai][bj][m][n], 0, 0, 0); \
               acc[ai][bj][m][n] = __builtin_amdgcn_mfma_f32_16x16x32_bf16(PG_HI(Bt[n]), PG_HI(At[m]), acc[ai][bj][m][n], 0, 0, 0); } } \
        __builtin_amdgcn_s_setprio(0); } while (0)
#define PG_WAIT_V(n) asm volatile("s_waitcnt vmcnt(" #n ")" ::: "memory")
#define PG_WAIT_L(n) asm volatile("s_waitcnt lgkmcnt(" #n ")" ::: "memory")
#define PG_BAR __builtin_amdgcn_s_barrier()
#define PG_SCHED __builtin_amdgcn_sched_barrier(0)
#define PG_AOFFS(dst, ord) do { _Pragma("unroll") for (int _h = 0; _h < 2; ++_h) _Pragma("unroll") for (int _i = 0; _i < 2; ++_i) \
        dst[_h][_i] = (unsigned)ltab[(ord) * 256 + _h * HALF + R2[_i]] * rowb + (unsigned)C2[_i] * 2u; } while (0)
    const LAS unsigned short* ltab = (const LAS unsigned short*)(lds + LTAB_OFF);
    if constexpr (GATHER) {
        Unit u0; for (int i = 0; i < 32 && S.next(i, u0); ++i) { if (tid < 256) ((LAS unsigned short*)(lds + LTAB_OFF))[i * 256 + tid] = (unsigned short)g.idx[u0.pm * BM + tid]; }
        __syncthreads();
    }
    if constexpr (Epi::PREP) { E.prep(tid); __syncthreads(); }
    Unit cur, nxt; int ui = 0;
    if (!S.next(0, cur)) return;

    f32x4 acc[2][2][4][2];
#define PG_ACC_INIT(u) do { if constexpr (Epi::INIT) { int t2 = tid; asm volatile("" : "+v"(t2)); E.init(acc, u, wr, wc, t2 & 15, (t2 & 63) >> 4); \
        _Pragma("unroll") for (int a = 0; a < 2; ++a) _Pragma("unroll") for (int b = 0; b < 2; ++b) _Pragma("unroll") for (int m = 0; m < 4; ++m) _Pragma("unroll") for (int n = 0; n < 2; ++n) asm volatile("" : "+v"(acc[a][b][m][n])); } \
      else { _Pragma("unroll") for (int a = 0; a < 2; ++a) _Pragma("unroll") for (int b = 0; b < 2; ++b) _Pragma("unroll") for (int m = 0; m < 4; ++m) _Pragma("unroll") for (int n = 0; n < 2; ++n) { \
            double z0_, z1_; asm volatile("v_mov_b64 %0, 0" : "=v"(z0_)); asm volatile("v_mov_b64 %0, 0" : "=v"(z1_)); acc[a][b][m][n] = __builtin_bit_cast(f32x4, (f64x2){z0_, z1_}); } } } while (0)
    PG_ACC_INIT(cur);
    i32x8 At[4], B0[2], B1[2];
    unsigned vA[2][2], vN[2][2];
    if constexpr (GATHER) { PG_AOFFS(vA, 0); }
    const char* cA = GATHER ? g.A : g.A + (size_t)cur.pm * tstep;
    const char* cB = g.Bt + (size_t)(cur.pm >> g.gshift) * g.gstride + (size_t)cur.pn * tstep;
#define PG_STAGE_A(bufoff, ptr, h) do { if constexpr (GATHER) { PG_STAGE(bufoff, ptr, vA[h]); } else { PG_STAGE(bufoff, (ptr) + (h) * hstep, voffB); } } while (0)
    PG_STAGE(PG_SB(0, 0), cB, voffB); PG_STAGE(PG_SB(0, 1), cB + hstep, voffB); PG_STAGE_A(PG_SA(0, 0), cA, 0); PG_STAGE_A(PG_SA(0, 1), cA, 1);
    if (wr == 1) PG_BAR;
    PG_WAIT_V(2); PG_BAR;
    PG_STAGE(PG_SB(1, 0), cB + kstep, voffB); PG_STAGE_A(PG_SA(1, 0), cA + kstep, 0); PG_STAGE(PG_SB(1, 1), cB + hstep + kstep, voffB);
    PG_WAIT_V(6); PG_BAR;
    for (;;) {
        const bool has_next = S.next(ui + 1, nxt);
        if constexpr (GATHER) { if (has_next) { PG_AOFFS(vN, ui + 1); } else {
#pragma unroll
            for (int _h = 0; _h < 2; ++_h)
#pragma unroll
                for (int _i = 0; _i < 2; ++_i) vN[_h][_i] = vA[_h][_i]; } }
        const char* nA = GATHER ? g.A : (has_next ? g.A + (size_t)nxt.pm * tstep : cA);
        const char* nB = has_next ? g.Bt + (size_t)(nxt.pm >> g.gshift) * g.gstride + (size_t)nxt.pn * tstep : cB;
#pragma unroll 1
        for (int t = 0; t < nt; t += 2) {
            const bool last = (t == nt - 2);
            unsigned la = (unsigned)aoff, lb = (unsigned)boff + 65536u; asm volatile("" : "+v"(la), "+v"(lb));
            asm volatile("" : "+v"(voffB[0]), "+v"(voffB[1]));
            if constexpr (GATHER) asm volatile("" : "+v"(vA[0][0]), "+v"(vA[0][1]), "+v"(vA[1][0]), "+v"(vA[1][1]));
            if constexpr (Epi::MID) { if (t == nt / 2) { int t2 = tid; asm volatile("" : "+v"(t2)); E.mid(acc, cur, wr, wc, t2 & 15, (t2 & 63) >> 4); } }
            const char* a1 = cA + (size_t)(t + 1) * kstep;
            const char* a2 = last ? nA : cA + (size_t)(t + 2) * kstep; const char* b2 = last ? nB : cB + (size_t)(t + 2) * kstep;
            const char* a3 = a2 + kstep; const char* b3 = b2 + kstep;
            PG_LDB(B0, 0, 0); PG_LDB(B1, 0, 1); PG_SCHED; PG_LDA(At, 0, 0); PG_STAGE_A(PG_SA(1, 1), a1, 1);
            if constexpr (GATHER) { if (last) {
#pragma unroll
                for (int _h = 0; _h < 2; ++_h)
#pragma unroll
                    for (int _i = 0; _i < 2; ++_i) vA[_h][_i] = vN[_h][_i]; } }
            PG_WAIT_V(8); PG_WAIT_L(0); PG_BAR; PG_MMA(0, 0, At, B0); PG_MMA(0, 1, At, B1); PG_BAR; PG_SCHED;
            PG_LDA(At, 0, 1); PG_STAGE(PG_SB(0, 0), b2, voffB); PG_STAGE(PG_SB(0, 1), b2 + hstep, voffB); PG_STAGE_A(PG_SA(0, 0), a2, 0);
            PG_WAIT_V(8); PG_WAIT_L(0); PG_BAR; PG_MMA(1, 0, At, B0); PG_MMA(1, 1, At, B1); PG_BAR; PG_SCHED;
            if constexpr (Epi::RSC) { if (last) { const float* rp = E.rsc() + cur.pm * BM + (wid & 3) * 64 + (tid & 63); __builtin_amdgcn_global_load_lds((const unsigned*)rp, (LAS unsigned*)(lds + RSC_OFF + wid * 256), 4, 0, 0); } }
            PG_LDB(B0, 1, 0); PG_LDB(B1, 1, 1); PG_SCHED; PG_LDA(At, 1, 0); PG_STAGE_A(PG_SA(0, 1), a2, 1);
            if constexpr (Epi::RSC) { if (last) PG_WAIT_V(9); else PG_WAIT_V(8); } else PG_WAIT_V(8);
            PG_WAIT_L(0); PG_BAR; PG_MMA(0, 0, At, B0); PG_MMA(0, 1, At, B1); PG_BAR; PG_SCHED;
            PG_LDA(At, 1, 1); PG_STAGE(PG_SB(1, 0), b3, voffB); PG_STAGE(PG_SB(1, 1), b3 + hstep, voffB); PG_STAGE_A(PG_SA(1, 0), a3, 0);
            PG_WAIT_V(8); PG_WAIT_L(0); PG_BAR; PG_MMA(1, 0, At, B0); PG_MMA(1, 1, At, B1); PG_BAR; PG_SCHED;
        }
        if (wr == 0) PG_BAR;
        { int t2 = tid; Unit cu2 = cur; asm volatile("" : "+v"(t2), "+s"(cu2.pm), "+s"(cu2.pn)); E(acc, cu2, wr, wc, t2 & 15, (t2 & 63) >> 4); }
        if (!has_next) break;
        PG_ACC_INIT(nxt);
        cur = nxt; cA = nA; cB = nB; ++ui;
        if (wr == 1) PG_BAR;
    }
    PG_WAIT_V(0);
    PG_BAR;
#undef PG_SA
#undef PG_SB
#undef PG_STAGE
#undef PG_LDA
#undef PG_LDB
#undef PG_MMA
#undef PG_LD16
#undef PG_CAT2
#undef PG_LO
#undef PG_HI
#undef PG_WAIT_V
#undef PG_WAIT_L
#undef PG_BAR
#undef PG_SCHED
#undef PG_AOFFS
#undef PG_ACC_INIT
#undef PG_STAGE_A
}
}

typedef f32x4 AccT[2][2][4][2];
__device__ __forceinline__ u32x2 pack8_fp8(const f32x4 a, const f32x4 b) { int w0 = 0, w1 = 0; w0 = __builtin_amdgcn_cvt_pk_fp8_f32(a[0], a[1], w0, false); w0 = __builtin_amdgcn_cvt_pk_fp8_f32(a[2], a[3], w0, true);
    w1 = __builtin_amdgcn_cvt_pk_fp8_f32(b[0], b[1], w1, false); w1 = __builtin_amdgcn_cvt_pk_fp8_f32(b[2], b[3], w1, true); return (u32x2){(unsigned)w0, (unsigned)w1}; }
__device__ __forceinline__ u32x4 pack8(const f32x4 a, const f32x4 b) { u32x4 w; w.x = pk2(a[0], a[1]); w.y = pk2(a[2], a[3]); w.z = pk2(b[0], b[1]); w.w = pk2(b[2], b[3]); return w; }
__device__ __forceinline__ void unpack8(const u32x4 w, f32x4& a, f32x4& b) { a = (f32x4){bflo2f(w.x), bfhi2f(w.x), bflo2f(w.y), bfhi2f(w.y)}; b = (f32x4){bflo2f(w.z), bfhi2f(w.z), bflo2f(w.w), bfhi2f(w.w)}; }

__device__ __forceinline__ f32x4 inv1pexp2(const f32x4 e) { f32x4 d;
#pragma unroll
    for (int j = 0; j < 4; ++j) d[j] = __builtin_amdgcn_exp2f(min1(e[j], 60.0f));
    d = d + 1.0f;
    const f32x2 dlo = __builtin_shufflevector(d, d, 0, 1), dhi = __builtin_shufflevector(d, d, 2, 3), p = dlo * dhi;
    const f32x2 r = (f32x2){fast_rcp(p[0]), fast_rcp(p[1])};
    const f32x2 ilo = r * dhi, ihi = r * dlo;
    return __builtin_shufflevector(ilo, ihi, 0, 1, 2, 3); }
__device__ __forceinline__ f32x4 gelu4(const f32x4 x) { const f32x4 x2 = x * x; const f32x4 c = x2 * -0.1029432404f + -2.3022081981f; return x * inv1pexp2(x * c); }
template <bool F8> struct EpiInT {
    static constexpr bool MID = false, INIT = false, RSC = false, PREP = true;
    static constexpr float ASC = F8 ? 1.0f / WSCALE : 1.0f;
    bf16 *UG, *VG, *Q, *KB, *VB; unsigned short* G8; const float *bgate, *qg, *kg; LAS float* PL;
    __device__ __forceinline__ void prep(int tid) const {
        for (int i = tid; i < 2 * D / 4; i += NTHREADS) *(LAS f32x4*)(PL + 4 * i) = *(const f32x4*)(bgate + 4 * i);
        if (tid < 16) *(LAS f32x4*)(PL + 2 * D + 4 * tid) = *(const f32x4*)(qg + 4 * tid);
        else if (tid < 32) *(LAS f32x4*)(PL + 2 * D + 4 * tid) = *(const f32x4*)(kg + 4 * (tid - 16));
    }
    __device__ __forceinline__ void operator()(const AccT& acc, const pg::Unit& u, int wr, int wc, int fr, int fq) const {
        const int row0 = u.pm * 256 + wr * 64 + fr, pn = u.pn + (F8 ? 4 : 0);
        if (pn < 4) {
            bf16* base = (pn < 2 ? UG : VG) + (pn & 1) * 256 + 64 * wc + 8 * fq;
#pragma unroll
            for (int ai = 0; ai < 2; ++ai)
#pragma unroll
                for (int m = 0; m < 4; ++m) { bf16* rowp = base + (size_t)(row0 + ai * 128 + m * 16) * AW;
#pragma unroll
                    for (int bj = 0; bj < 2; ++bj) __builtin_nontemporal_store(pack8(gelu4(acc[ai][bj][m][0]), gelu4(acc[ai][bj][m][1])), (u32x4*)(rowp + 32 * bj)); }
        } else if (pn < 7) {
            const bool isq = pn < 6, norm = isq || wc < 2;
            const LAS float* gp = PL + 2 * D + (isq ? 0 : 64); const float sc = isq ? 0.125f * 1.4426950408889634f : 1.0f;
            f32x4 gv[2][2];
#pragma unroll
            for (int bj = 0; bj < 2; ++bj)
#pragma unroll
                for (int n = 0; n < 2; ++n) gv[bj][n] = *(const LAS f32x4*)(gp + 32 * bj + 8 * fq + 4 * n) * sc;
            bf16* base; int ld;
            if (isq) { base = Q + (pn - 4) * 256 + 64 * wc + 8 * fq; ld = BW; }
            else if (wc < 2) { base = KB + 64 * wc + 8 * fq; ld = KVW; }
            else { base = VB + 64 * (wc - 2) + 8 * fq; ld = KVW; }
#pragma unroll
            for (int ai = 0; ai < 2; ++ai)
#pragma unroll
                for (int m = 0; m < 4; ++m) { bf16* rowp = base + (size_t)(row0 + ai * 128 + m * 16) * ld;
                    float ss = 0.f;
#pragma unroll
                    for (int bj = 0; bj < 2; ++bj)
#pragma unroll
                        for (int n = 0; n < 2; ++n) { const f32x4 x = acc[ai][bj][m][n] * ASC; ss += (x[0] * x[0] + x[1] * x[1]) + (x[2] * x[2] + x[3] * x[3]); }
                    ss += __shfl_xor(ss, 16); ss += __shfl_xor(ss, 32);
                    const float rstd = norm ? rsqrtf(ss * (1.0f / 64.0f) + EPS) : 1.0f;
#pragma unroll
                    for (int bj = 0; bj < 2; ++bj) { f32x4 v0 = acc[ai][bj][m][0] * ASC, v1 = acc[ai][bj][m][1] * ASC;
                        if (norm) { v0 = v0 * rstd * gv[bj][0]; v1 = v1 * rstd * gv[bj][1]; }
                        __builtin_nontemporal_store(pack8(v0, v1), (u32x4*)(rowp + 32 * bj)); } }
        } else {
            const int c0 = 128 * (pn - 7) + 32 * wc + 8 * fq;
            f32x4 ba[2], bb[2];
#pragma unroll
            for (int n = 0; n < 2; ++n) { ba[n] = *(const LAS f32x4*)(PL + c0 + 4 * n) * -1.4426950408889634f; bb[n] = *(const LAS f32x4*)(PL + D + c0 + 4 * n) * -1.4426950408889634f; }
#pragma unroll
            for (int ai = 0; ai < 2; ++ai)
#pragma unroll
                for (int m = 0; m < 4; ++m) { const size_t ro = (size_t)(row0 + ai * 128 + m * 16) * D + c0;
                    unsigned wd[4];
#pragma unroll
                    for (int n = 0; n < 2; ++n) { f32x4 ea = acc[ai][0][m][n] * (-1.4426950408889634f * ASC) + ba[n], eb = acc[ai][1][m][n] * (-1.4426950408889634f * ASC) + bb[n], da, db;
#pragma unroll
                        for (int j = 0; j < 4; ++j) { da[j] = __builtin_amdgcn_exp2f(min1(ea[j], 43.0f)); db[j] = __builtin_amdgcn_exp2f(min1(eb[j], 43.0f)); }
                        da = da + 1.0f; db = db + 1.0f;
                        const f32x4 p = da * db; f32x4 r;
#pragma unroll
                        for (int j = 0; j < 4; ++j) r[j] = fast_rcp(p[j]);
                        r = r * 255.0f;
                        const f32x4 qa = db * r + 0.5f; f32x4 qb = da * r + 0.5f;
#pragma unroll
                        for (int j = 0; j < 4; ++j) qb[j] = max1(qb[j], 1.0f);
#pragma unroll
                        for (int k = 0; k < 2; ++k) { unsigned w_ = 0u;
                            w_ = __builtin_amdgcn_cvt_pk_u8_f32(qa[2 * k], 0u, w_); w_ = __builtin_amdgcn_cvt_pk_u8_f32(qb[2 * k], 1u, w_);
                            w_ = __builtin_amdgcn_cvt_pk_u8_f32(qa[2 * k + 1], 2u, w_); w_ = __builtin_amdgcn_cvt_pk_u8_f32(qb[2 * k + 1], 3u, w_); wd[2 * n + k] = w_; } }
                    u32x4 w; w.x = wd[0]; w.y = wd[1]; w.z = wd[2]; w.w = wd[3];
                    __builtin_nontemporal_store(w, (u32x4*)(G8 + ro)); }
        }
    }
};
struct EpiProj {
    static constexpr bool MID = true, INIT = false, RSC = false, PREP = false;
    const unsigned short* G8; bf16* MG;
    __device__ __forceinline__ void mid(AccT& acc, const pg::Unit& u, int wr, int wc, int fr, int fq) const {
        unsigned off = (unsigned)((wr * 64 + fr) * D + 64 * wc + 8 * fq) * 2u; asm volatile("" : "+v"(off));
        const char* base = (const char*)G8 + ((size_t)u.pm * 256 * D + (size_t)u.pn * 256) * 2;
#pragma unroll
        for (int ai = 0; ai < 2; ++ai) {
#pragma unroll
            for (int m = 0; m < 4; ++m) {
#pragma unroll
                for (int bj = 0; bj < 2; ++bj) { const u32x4 w = *(const u32x4*)(base + (off + (unsigned)(((ai * 128 + m * 16) * D + 32 * bj) * 2)));
                    const unsigned ww[4] = {w.x, w.y, w.z, w.w}; f32x4 r0, r1;
#pragma unroll
                    for (int k = 0; k < 4; ++k) { const float qa0 = (float)(ww[k] & 0xffu), qb0 = (float)((ww[k] >> 8) & 0xffu), qa1 = (float)((ww[k] >> 16) & 0xffu), qb1 = (float)(ww[k] >> 24);
                        const float rr = fast_rcp(qb0 * qb1); const float v0 = qa0 * (rr * qb1), v1 = qa1 * (rr * qb0);
                        if (k < 2) { r0[2 * k] = v0; r0[2 * k + 1] = v1; } else { r1[2 * (k - 2)] = v0; r1[2 * (k - 2) + 1] = v1; } }
                    acc[ai][bj][m][0] *= r0; acc[ai][bj][m][1] *= r1; } }
        }
    }
    __device__ __forceinline__ void operator()(const AccT& acc, const pg::Unit& u, int wr, int wc, int fr, int fq) const {
        const int row0 = u.pm * 256 + wr * 64 + fr, col0 = u.pn * 256 + 64 * wc + 8 * fq;
#pragma unroll
        for (int ai = 0; ai < 2; ++ai)
#pragma unroll
            for (int m = 0; m < 4; ++m) { const size_t ro = (size_t)(row0 + ai * 128 + m * 16) * D + col0;
#pragma unroll
                for (int bj = 0; bj < 2; ++bj) { const u32x4 w = *(const u32x4*)(G8 + ro + 32 * bj); const unsigned ww[4] = {w.x, w.y, w.z, w.w}; f32x4 g0, g1;
#pragma unroll
                    for (int k = 0; k < 4; ++k) { const float b0 = (float)((ww[k] >> 8) & 0xffu) * (1.0f / 255.0f), b1 = (float)(ww[k] >> 24) * (1.0f / 255.0f);
                        if (k < 2) { g0[2 * k] = b0; g0[2 * k + 1] = b1; } else { g1[2 * (k - 2)] = b0; g1[2 * (k - 2) + 1] = b1; } }
                    *(u32x4*)(MG + ro + 32 * bj) = pack8(acc[ai][bj][m][0] * g0, acc[ai][bj][m][1] * g1); } }
    }
};
struct EpiOut {
    static constexpr bool MID = false, INIT = true, RSC = false, PREP = false;
    const bf16* H0; const float* IRS0; const float* IG1; bf16* X1B;
    __device__ __forceinline__ void init(AccT& acc, const pg::Unit& u, int wr, int wc, int fr, int fq) const {
        const int row0 = u.pm * 256 + wr * 64 + fr, col0 = u.pn * 256 + 64 * wc + 8 * fq;
        f32x4 ig[2][2];
#pragma unroll
        for (int bj = 0; bj < 2; ++bj)
#pragma unroll
            for (int n = 0; n < 2; ++n) ig[bj][n] = *(const f32x4*)(IG1 + col0 + 32 * bj + 4 * n);
#pragma unroll
        for (int ai = 0; ai < 2; ++ai)
#pragma unroll
            for (int m = 0; m < 4; ++m) { const int row = row0 + ai * 128 + m * 16; const size_t ro = (size_t)row * D + col0; const float ir = IRS0[row];
#pragma unroll
                for (int bj = 0; bj < 2; ++bj) { f32x4 a, b; unpack8(*(const u32x4*)(H0 + ro + 32 * bj), a, b); acc[ai][bj][m][0] = a * ir * ig[bj][0]; acc[ai][bj][m][1] = b * ir * ig[bj][1]; } }
    }
    __device__ __forceinline__ void operator()(const AccT& acc, const pg::Unit& u, int wr, int wc, int fr, int fq) const {
        const int row0 = u.pm * 256 + wr * 64 + fr, col0 = u.pn * 256 + 64 * wc + 8 * fq;
#pragma unroll
        for (int ai = 0; ai < 2; ++ai)
#pragma unroll
            for (int m = 0; m < 4; ++m) { const size_t ro = (size_t)(row0 + ai * 128 + m * 16) * D + col0;
#pragma unroll
                for (int bj = 0; bj < 2; ++bj) *(u32x4*)(X1B + ro + 32 * bj) = pack8(acc[ai][bj][m][0], acc[ai][bj][m][1]); }
    }
};
struct EpiGU {
    static constexpr bool MID = false, INIT = false, RSC = true, PREP = false;
    const float* RS; unsigned char* HID; const LAS float* RSL;
    __device__ __forceinline__ const float* rsc() const { return RS; }
    __device__ __forceinline__ void operator()(const AccT& acc, const pg::Unit& u, int wr, int wc, int fr, int fq) const {
        const int row0 = u.pm * 256 + wr * 64 + fr, col0 = u.pn * 128 + 32 * wc + 8 * fq;
#pragma unroll
        for (int ai = 0; ai < 2; ++ai)
#pragma unroll
            for (int m = 0; m < 4; ++m) { const int row = row0 + ai * 128 + m * 16; const float rs = RSL[wr * 64 + fr + ai * 128 + m * 16] * (1.0f / WSCALE), rs2 = rs * rs, nrl = rs * -1.4426950408889634f;
                f32x4 h[2];
#pragma unroll
                for (int n = 0; n < 2; ++n) { const f32x4 ag = acc[ai][0][m][n], au = acc[ai][1][m][n]; h[n] = (ag * au * rs2) * inv1pexp2(ag * nrl); }
                *(u32x2*)(HID + (size_t)row * FF + col0) = pack8_fp8(h[0], h[1]); }
    }
};
struct EpiDown {
    static constexpr bool MID = false, INIT = false, RSC = true, PREP = false;
    const float* GATEV; unsigned char* Y; const LAS float* RSL;
    __device__ __forceinline__ const float* rsc() const { return GATEV; }
    __device__ __forceinline__ void operator()(const AccT& acc, const pg::Unit& u, int wr, int wc, int fr, int fq) const {
        const int row0 = u.pm * 256 + wr * 64 + fr, col0 = u.pn * 256 + 64 * wc + 8 * fq;
#pragma unroll
        for (int ai = 0; ai < 2; ++ai)
#pragma unroll
            for (int m = 0; m < 4; ++m) { const int row = row0 + ai * 128 + m * 16; const float gt = RSL[wr * 64 + fr + ai * 128 + m * 16] * (YSCALE / WSCALE); unsigned char* yp = Y + (size_t)row * D + col0;
#pragma unroll
                for (int bj = 0; bj < 2; ++bj) *(u32x2*)(yp + 32 * bj) = pack8_fp8(acc[ai][bj][m][0] * gt, acc[ai][bj][m][1] * gt); }
    }
};

__device__ __forceinline__ float wave_sum(float v) {
#pragma unroll
    for (int o = 1; o < 64; o <<= 1) v += __shfl_xor(v, o);
    return v;
}
template <int MAPID> __device__ __forceinline__ int drow(int c) {
    if (MAPID == 0) { if (c < 1792) return 256 * (c >> 8) + inv_bf16(c & 255); if (c < 2816) { const int g = c - 1792; return 256 * (7 + (g >> 7)) + inv_pair(0, g & 127); } const int g = c - 2816; return 256 * (7 + (g >> 7)) + inv_pair(1, g & 127); }
    if (MAPID == 1) return 256 * (c >> 8) + inv_bf16(c & 255);
    if (MAPID == 2) return 256 * (c >> 8) + inv_f32(c & 255);
    if (MAPID == 5) return drow<0>(c + 1024) - 1024;
    if (MAPID == 3) return 256 * (c >> 7) + inv_pair(0, c & 127);
    return 256 * (c >> 7) + inv_pair(1, c & 127);
}
template <int MAPID> __device__ __forceinline__ void p0_item(const float* W, int ld, int nblk, bf16* WT, int Kd, int koff, LAS float* scr, int item, int lane) {
    const int kb = item / nblk, nb = item % nblk, k0 = 64 * kb, n0 = 32 * nb;
    float wv[32];
#pragma unroll
    for (int i = 0; i < 32; ++i) wv[i] = __builtin_nontemporal_load(W + (size_t)(k0 + 2 * i + (lane >> 5)) * ld + n0 + (lane & 31));
#pragma unroll
    for (int i = 0; i < 32; ++i) scr[(2 * i + (lane >> 5)) * 33 + (lane & 31)] = wv[i];
    asm volatile("s_waitcnt lgkmcnt(0)" ::: "memory");
    const int c = lane & 7;
#pragma unroll
    for (int j = 0; j < 4; ++j) { const int n = (lane >> 3) + 8 * j; const LAS float* s = scr + (8 * c) * 33 + n;
        u32x4 o; o.x = pk2(s[0 * 33], s[1 * 33]); o.y = pk2(s[2 * 33], s[3 * 33]); o.z = pk2(s[4 * 33], s[5 * 33]); o.w = pk2(s[6 * 33], s[7 * 33]);
        *(u32x4*)(WT + (size_t)drow<MAPID>(n0 + n) * Kd + koff + k0 + 8 * c) = o; }
    asm volatile("s_waitcnt lgkmcnt(0)" ::: "memory");
}
template <int MAPID> __device__ __forceinline__ void p0_item8(const float* W, int ld, int nblk, unsigned char* WT, int Kd, float scale, LAS float* scr, int item, int lane) {
    const int kb = item / nblk, nb = item % nblk, k0 = 64 * kb, n0 = 32 * nb;
    float wv[32];
#pragma unroll
    for (int i = 0; i < 32; ++i) wv[i] = __builtin_nontemporal_load(W + (size_t)(k0 + 2 * i + (lane >> 5)) * ld + n0 + (lane & 31));
#pragma unroll
    for (int i = 0; i < 32; ++i) scr[(2 * i + (lane >> 5)) * 33 + (lane & 31)] = wv[i] * scale;
    asm volatile("s_waitcnt lgkmcnt(0)" ::: "memory");
    const int c = lane & 7;
#pragma unroll
    for (int j = 0; j < 4; ++j) { const int n = (lane >> 3) + 8 * j; const LAS float* s = scr + (8 * c) * 33 + n;
        const f32x4 a = (f32x4){s[0 * 33], s[1 * 33], s[2 * 33], s[3 * 33]}, b = (f32x4){s[4 * 33], s[5 * 33], s[6 * 33], s[7 * 33]};
        __builtin_nontemporal_store(pack8_fp8(a, b), (u32x2*)(WT + (size_t)drow<MAPID>(n0 + n) * Kd + k0 + 8 * c)); }
    asm volatile("s_waitcnt lgkmcnt(0)" ::: "memory");
}
struct P0Args { float* IRS0; float* IG1; const float *x, *g1, *w_in, *wpa, *wpb, *wout, *wsp, *g2, *wr, *wg, *wu, *wd; bf16 *WIN, *WPROJ, *WOUT, *WSP, *WRH, *WRL; unsigned char *WGU, *WDN; bf16* H; unsigned char *WIN8, *H0F8; };
__device__ __forceinline__ void p0_prologue(LAS unsigned char* lds, const P0Args& a, int gw, int NGW, int wave, int lane, int gtid, int NGT) {
    LAS float* scr = (LAS float*)(lds + wave * 16384);
    constexpr int I_IN = 16 * 120, I_IN8 = 16 * 88, I_PA = 8 * 32, I_OUT = 16 * 32, I_G = 16 * 64, I_D = 32 * 32;
    constexpr int NITEMS = I_IN + I_IN8 + 2 * I_PA + I_OUT + NE * (2 * I_G + I_D);
#ifndef MK_P0W
#define MK_P0W 1
#define MK_P0H 1
#endif
    for (int rpw = 0; rpw < MK_P0W; ++rpw)
    for (int it = gw; it < NITEMS; it += NGW) {
        int r = it;
        if (r < I_IN) { p0_item<0>(a.w_in, INC, 120, a.WIN, D, 0, scr, r, lane); continue; } r -= I_IN;
        if (r < I_IN8) { p0_item8<5>(a.w_in + 1024, INC, 88, a.WIN8, D, WSCALE, scr, r, lane); continue; } r -= I_IN8;
        if (r < I_PA) { p0_item<1>(a.wpa, D, 32, a.WPROJ, D, 0, scr, r, lane); continue; } r -= I_PA;
        if (r < I_PA) { p0_item<1>(a.wpb, D, 32, a.WPROJ, D, 512, scr, r, lane); continue; } r -= I_PA;
        if (r < I_OUT) { p0_item<1>(a.wout, D, 32, a.WOUT, D, 0, scr, r, lane); continue; } r -= I_OUT;
        if (r < NE * I_G) { const int e = r / I_G; p0_item8<3>(a.wg + (size_t)e * D * FF, FF, 64, a.WGU + (size_t)e * 4096 * D, D, WSCALE, scr, r % I_G, lane); continue; } r -= NE * I_G;
        if (r < NE * I_G) { const int e = r / I_G; p0_item8<4>(a.wu + (size_t)e * D * FF, FF, 64, a.WGU + (size_t)e * 4096 * D, D, WSCALE, scr, r % I_G, lane); continue; } r -= NE * I_G;
        { const int e = r / I_D; p0_item8<1>(a.wd + (size_t)e * FF * D, D, 32, a.WDN + (size_t)e * D * FF, FF, WSCALE, scr, r % I_D, lane); }
    }
    for (int i = gtid; i < 8 * 128 * 128 / 4; i += NGT) { const f32x4 v = *(const f32x4*)(a.wsp + 4 * (size_t)i); u32x2 o; o.x = pk2(v[0], v[1]); o.y = pk2(v[2], v[3]); *(u32x2*)(a.WSP + 4 * (size_t)i) = o; }
    for (int i = gtid; i < D; i += NGT) a.IG1[i] = 1.0f / a.g1[i];
    for (int i = gtid; i < NE * D; i += NGT) { const int e = i >> 10, k = i & 1023; const float v = a.wr[k * NE + e]; const bf16 h = f2bf(v); a.WRH[i] = h; a.WRL[i] = f2bf(v - bf2f(h)); }
    for (int rph = 0; rph < MK_P0H; ++rph)
    for (int m0 = gw; m0 < T; m0 += 4 * NGW) {
        f32x4 v[4][4]; float ssum[4];
#pragma unroll
        for (int r = 0; r < 4; ++r) { const f32x4* xr = (const f32x4*)(a.x + (size_t)(m0 + r * NGW) * D) + lane;
#pragma unroll
            for (int j = 0; j < 4; ++j) v[r][j] = __builtin_nontemporal_load(xr + 64 * j); }
#pragma unroll
        for (int r = 0; r < 4; ++r) { float s_ = 0.f;
#pragma unroll
            for (int j = 0; j < 4; ++j) s_ += (v[r][j][0] * v[r][j][0] + v[r][j][1] * v[r][j][1]) + (v[r][j][2] * v[r][j][2] + v[r][j][3] * v[r][j][3]);
            ssum[r] = wave_sum(s_); }
#pragma unroll
        for (int r = 0; r < 4; ++r) { const float rstd = rsqrtf(ssum[r] * (1.0f / D) + EPS); if (lane == 0) a.IRS0[m0 + r * NGW] = 1.0f / rstd; u32x2* o8 = (u32x2*)(a.H + (size_t)(m0 + r * NGW) * D) + lane;
#pragma unroll
            for (int j = 0; j < 4; ++j) { const f32x4 gg = *((const f32x4*)a.g1 + lane + 64 * j); const f32x4 y = v[r][j] * rstd * gg; u32x2 o; o.x = pk2(y[0], y[1]); o.y = pk2(y[2], y[3]); o8[64 * j] = o;
                int w8 = 0; w8 = __builtin_amdgcn_cvt_pk_fp8_f32(y[0], y[1], w8, false); w8 = __builtin_amdgcn_cvt_pk_fp8_f32(y[2], y[3], w8, true);
                ((unsigned*)(a.H0F8 + (size_t)(m0 + r * NGW) * D))[lane + 64 * j] = (unsigned)w8; } }
    }
}

__device__ __forceinline__ bf16x8 tr_pair(const LAS unsigned char* p0, const LAS unsigned char* p1) {
    const s16x4 a = __builtin_bit_cast(s16x4, __builtin_amdgcn_ds_read_tr16_b64_v4i16((LAS s16x4*)p0));
    const s16x4 b = __builtin_bit_cast(s16x4, __builtin_amdgcn_ds_read_tr16_b64_v4i16((LAS s16x4*)p1));
    return (bf16x8){a[0], a[1], a[2], a[3], b[0], b[1], b[2], b[3]};
}
constexpr int SP_STRIDE = 144, SP_IMG = 128 * SP_STRIDE, SP_PART = 8 * SP_IMG, SP_RSTD = SP_PART + 8 * 128 * 4, SP_END = SP_RSTD + 512;
__device__ __forceinline__ void spatial_unit(LAS unsigned char* lds, int bc, const bf16* UG, const bf16* VG, const float* vng, const bf16* WSP, const float* bsp, bf16* AO, int wave, int lane, int tid) {
    const int g = wave; const size_t row0 = (size_t)bc * 128;
    LAS unsigned char* img = lds + wave * SP_IMG; LAS float* part = (LAS float*)(lds + SP_PART); LAS float* rstd = (LAS float*)(lds + SP_RSTD);
    const int c8 = lane & 7, qr = lane >> 3;
    u32x4 v[16];
#pragma unroll
    for (int it = 0; it < 16; ++it) v[it] = *(const u32x4*)(VG + (row0 + 8 * it + qr) * AW + g * 64 + c8 * 8);
#pragma unroll
    for (int it = 0; it < 16; ++it) { f32x4 a, b; unpack8(v[it], a, b); float s = (a[0] * a[0] + a[1] * a[1]) + (a[2] * a[2] + a[3] * a[3]) + (b[0] * b[0] + b[1] * b[1]) + (b[2] * b[2] + b[3] * b[3]);
        s += __shfl_xor(s, 1); s += __shfl_xor(s, 2); s += __shfl_xor(s, 4); if (c8 == 0) part[g * 128 + 8 * it + qr] = s; }
    __syncthreads();
    if (tid < 128) { float t = 0.f;
#pragma unroll
        for (int w = 0; w < 8; ++w) t += part[w * 128 + tid];
        rstd[tid] = rsqrtf(t * (1.0f / AW) + EPS); }
    __syncthreads();
    const f32x4 g0 = *(const f32x4*)(vng + g * 64 + c8 * 8), g1 = *(const f32x4*)(vng + g * 64 + c8 * 8 + 4);
#pragma unroll
    for (int it = 0; it < 16; ++it) { const int q = 8 * it + qr; const float r = rstd[q]; f32x4 a, b; unpack8(v[it], a, b); *(LAS u32x4*)(img + q * SP_STRIDE + c8 * 16) = pack8(a * r * g0, b * r * g1); }
    asm volatile("s_waitcnt lgkmcnt(0)" ::: "memory");
    const int fr = lane & 15, fq = lane >> 4, qq = (lane & 15) >> 2, p4 = lane & 3;
    const bf16* wg = WSP + (size_t)g * 128 * 128;
#pragma unroll 1
    for (int nh = 0; nh < 2; ++nh) {
        f32x4 acc[4][4];
        u32x4 uu[4][2]; float bsv[4];
#pragma unroll
        for (int nb = 0; nb < 4; ++nb) { const int p = 64 * nh + 16 * nb + fr; const size_t ro = (row0 + p); bsv[nb] = bsp[g * 128 + p];
            uu[nb][0] = *(const u32x4*)(UG + ro * AW + g * 64 + 16 * fq); uu[nb][1] = *(const u32x4*)(UG + ro * AW + g * 64 + 16 * fq + 8); }
#pragma unroll
        for (int mb = 0; mb < 4; ++mb)
#pragma unroll
            for (int nb = 0; nb < 4; ++nb) acc[mb][nb] = (f32x4){0.f, 0.f, 0.f, 0.f};
#pragma unroll
        for (int kb = 0; kb < 4; ++kb) {
            bf16x8 af[4];
#pragma unroll
            for (int mb = 0; mb < 4; ++mb) { const LAS unsigned char* p = img + (32 * kb + 8 * fq + qq) * SP_STRIDE + (16 * p4 + 4 * mb) * 2; af[mb] = tr_pair(p, p + 4 * SP_STRIDE); }
#pragma unroll
            for (int nb = 0; nb < 4; ++nb) { const bf16x8 bfr = *(const bf16x8*)(wg + (size_t)(64 * nh + 16 * nb + fr) * 128 + 32 * kb + 8 * fq);
#pragma unroll
                for (int mb = 0; mb < 4; ++mb) acc[mb][nb] = __builtin_amdgcn_mfma_f32_16x16x32_bf16(af[mb], bfr, acc[mb][nb], 0, 0, 0); }
        }
#pragma unroll
        for (int nb = 0; nb < 4; ++nb) { const int p = 64 * nh + 16 * nb + fr; const float bs = bsv[nb]; const size_t ro = (row0 + p);
            const u32x4 u0 = uu[nb][0], u1 = uu[nb][1];
            f32x4 ua, ub, uc, ud; unpack8(u0, ua, ub); unpack8(u1, uc, ud);
            *(u32x4*)(AO + ro * D + g * 64 + 16 * fq) = pack8(ua * (acc[0][nb] + bs), ub * (acc[1][nb] + bs));
            *(u32x4*)(AO + ro * D + g * 64 + 16 * fq + 8) = pack8(uc * (acc[2][nb] + bs), ud * (acc[3][nb] + bs)); }
    }
    __syncthreads();
}
constexpr int AT_KSTR = 144, AT_VSTR = 160, AT_ROWS = 400, AT_K = 0, AT_V = AT_ROWS * AT_KSTR, AT_BIAS = AT_V + AT_ROWS * AT_VSTR, AT_BIASN = 304, AT_END = AT_BIAS + 8 * AT_BIASN * 4;
#define AT_LOAD_KV(bn_, kvh_) do { const int b_ = (bn_) >> 4, n_ = (bn_) & 15; _Pragma("unroll") for (int it = 0; it < 7; ++it) { const int c = tid + it * NTHREADS, s_ = c >> 3, ch = c & 7, pos = n_ * 128 - 128 + s_; \
        kv[it] = (u32x4){0u, 0u, 0u, 0u}; vv[it] = (u32x4){0u, 0u, 0u, 0u}; \
        if (s_ < 384 && pos >= 0 && pos < S) { const size_t ro = ((size_t)b_ * S + pos) * KVW + (kvh_) * 64 + ch * 8; kv[it] = *(const u32x4*)(KB + ro); vv[it] = *(const u32x4*)(VB + ro); } } } while (0)
#define AT_QBLOCK(EDGE_) do { \
            const int i0 = 64 * qh + 16 * qb, jb0 = 4 * qh + qb; const size_t qrow = brow + n * 128 + i0 + fr; \
            const bf16x8 q0 = qn0, q1 = qn1; \
            { const bf16* qx = qp + (size_t)((qb + 1) & 3) * 16 * BW; qn0 = *(const bf16x8*)qx; qn1 = *(const bf16x8*)(qx + 32); } \
            f32x4 sc[18]; float sum = 0.f; const LAS float* bl = bh + 16 + 4 * fq - fr; \
_Pragma("unroll") \
            for (int jbi = 0; jbi < 17; ++jbi) { const LAS unsigned char* kp = lds + AT_K + (16 * (jb0 + jbi) + fr) * AT_KSTR + 16 * fq; \
                const bf16x8 k0 = *(const LAS bf16x8*)kp, k1 = *(const LAS bf16x8*)(kp + 64); \
                f32x4 z = (f32x4){bl[16 * jbi], bl[16 * jbi + 1], bl[16 * jbi + 2], bl[16 * jbi + 3]}; \
                z = __builtin_amdgcn_mfma_f32_16x16x32_bf16(k0, q0, z, 0, 0, 0); z = __builtin_amdgcn_mfma_f32_16x16x32_bf16(k1, q1, z, 0, 0, 0); \
_Pragma("unroll") \
                for (int r = 0; r < 4; ++r) { const int xr = 16 * jbi + 4 * fq + r - fr; float p = __builtin_amdgcn_exp2f(z[r]); \
                    if (jbi == 0) p = (xr >= 0) ? p : 0.f; \
                    if (jbi == 16) p = (xr <= 256) ? p : 0.f; \
                    if (EDGE_) { const int pos = n * 128 - 128 + 16 * (jb0 + jbi) + 4 * fq + r; p = (pos >= 0 && pos < S) ? p : 0.f; } \
                    z[r] = p; sum += p; } \
                sc[jbi] = z; } \
            sc[17] = (f32x4){0.f, 0.f, 0.f, 0.f}; \
            sum += __shfl_xor(sum, 16); sum += __shfl_xor(sum, 32); \
            const float inv = fast_rcp(sum + __builtin_amdgcn_exp2f(snk * 1.4426950408889634f)); \
            f32x4 o[4]; \
_Pragma("unroll") \
            for (int mb = 0; mb < 4; ++mb) o[mb] = (f32x4){0.f, 0.f, 0.f, 0.f}; \
_Pragma("unroll") \
            for (int c = 0; c < 9; ++c) { const u32x4 pw = pack8(sc[2 * c], sc[2 * c + 1]); const bf16x8 pf = __builtin_bit_cast(bf16x8, pw); \
                const LAS unsigned char* vp = lds + AT_V + (16 * (jb0 + 2 * c) + 4 * fq + qq) * AT_VSTR + 8 * p4; \
_Pragma("unroll") \
                for (int mb = 0; mb < 4; ++mb) { const bf16x8 vf = tr_pair(vp + 32 * mb, vp + 32 * mb + 16 * AT_VSTR); o[mb] = __builtin_amdgcn_mfma_f32_16x16x32_bf16(vf, pf, o[mb], 0, 0, 0); } } \
            bf16* op = AO + qrow * D + 512 + h * 64 + 4 * fq; \
_Pragma("unroll") \
            for (int mb = 0; mb < 4; ++mb) { const f32x4 ov = o[mb] * inv; u32x2 w; w.x = pk2(ov[0], ov[1]); w.y = pk2(ov[2], ov[3]); *(u32x2*)(op + 16 * mb) = w; } \
        } while (0)
__device__ __forceinline__ void attn_units(LAS unsigned char* lds, int bid, int G, const bf16* Q, const bf16* KB, const bf16* VB, const float* sink, bf16* AO, int wave, int lane, int tid) {
    const LAS float* bias = (const LAS float*)(lds + AT_BIAS);
    const int fr = lane & 15, fq = lane >> 4, qq = (lane & 15) >> 2, p4 = lane & 3;
    const int nu = (NB * 16 - bid + G - 1) / G, npass = 2 * nu;
    u32x4 kv[7], vv[7];
    if (npass > 0) AT_LOAD_KV(bid, 0);
#pragma unroll 1
    for (int pp = 0; pp < npass; ++pp) {
        const int bn = bid + (pp >> 1) * G, kvh = pp & 1, b = bn >> 4, n = bn & 15; const size_t brow = (size_t)b * S;
        const int h = 4 * kvh + (wave & 3), qh = wave >> 2; const float snk = sink[h];
        const bf16* qp = Q + (brow + n * 128 + 64 * qh + fr) * BW + h * 64 + 8 * fq;
        bf16x8 qn0 = *(const bf16x8*)qp, qn1 = *(const bf16x8*)(qp + 32);
        __syncthreads();
#pragma unroll
        for (int it = 0; it < 7; ++it) { const int c = tid + it * NTHREADS, s_ = c >> 3, ch = c & 7;
            if (c < AT_ROWS * 8) { *(LAS u32x4*)(lds + AT_K + s_ * AT_KSTR + ch * 16) = kv[it]; *(LAS u32x4*)(lds + AT_V + s_ * AT_VSTR + ch * 16) = vv[it]; } }
        __syncthreads();
        if (pp + 1 < npass) AT_LOAD_KV(bid + ((pp + 1) >> 1) * G, (pp + 1) & 1);
        const bool edge = (n == 0) || (n == 15);
        const LAS float* bh = bias + h * AT_BIASN;
#pragma unroll 1
        for (int qb = 0; qb < 4; ++qb) { if (edge) { AT_QBLOCK(true); } else { AT_QBLOCK(false); } }
    }
}
#undef AT_LOAD_KV
#undef AT_QBLOCK
__device__ __forceinline__ void p2_mixers(LAS unsigned char* lds, int bid, int G, const bf16* UG, const bf16* VG, const float* vng, const bf16* WSP, const float* bsp,
                                          const bf16* Q, const bf16* KB, const bf16* VB, const float* sink, const float* relt, bf16* AO, int wave, int lane, int tid) {
    for (int u = bid; u < NB * 16; u += G) spatial_unit(lds, u, UG, VG, vng, WSP, bsp, AO, wave, lane, tid);
    __syncthreads();
    for (int i = tid; i < 8 * AT_BIASN; i += NTHREADS) { const int h = i / AT_BIASN, xx = i % AT_BIASN, rel = xx - 16 - 128; ((LAS float*)(lds + AT_BIAS))[i] = (rel >= -128 && rel <= 128) ? relt[t5_bucket(rel) * 8 + h] * 1.4426950408889634f : 0.f; }
    attn_units(lds, bid, G, Q, KB, VB, sink, AO, wave, lane, tid);
}

constexpr int P5_WSTR = 2 * D + 16, P5_WL = 16 * P5_WSTR, P5_G = 2 * P5_WL;
__device__ __forceinline__ void p5_router(LAS unsigned char* lds, const bf16* x1, const float* g2, const bf16* WRH, const bf16* WRL, unsigned char* H8, float* AFF, float* RSTD, int gw, int NGW, int lane, int tid) {
    const int fr = lane & 15, fq = lane >> 4;
    u32x4 xw[32];
    if (gw < T / 16) {
#pragma unroll
        for (int kb = 0; kb < 32; ++kb) xw[kb] = *(const u32x4*)(x1 + ((size_t)gw * 16 + fr) * D + 8 * fq + 32 * kb);
    }
    asm volatile("" ::: "memory");
    for (int i = tid; i < 16 * (D / 8); i += NTHREADS) { const int e = i >> 7, c = i & 127;
        *(LAS u32x4*)(lds + e * P5_WSTR + c * 16) = *(const u32x4*)(WRH + e * D + c * 8); *(LAS u32x4*)(lds + P5_WL + e * P5_WSTR + c * 16) = *(const u32x4*)(WRL + e * D + c * 8); }
    for (int i = tid; i < D / 4; i += NTHREADS) *(LAS f32x4*)(lds + P5_G + i * 16) = *(const f32x4*)(g2 + 4 * i);
    __syncthreads();
    const LAS unsigned char* whp = lds + fr * P5_WSTR + 16 * fq; const LAS unsigned char* gp = lds + P5_G + 32 * fq;
    for (int rb = gw; rb < T / 16; rb += NGW) {
        const size_t row = (size_t)rb * 16 + fr; const bf16* xr = x1 + row * D + 8 * fq; unsigned char* hr = H8 + row * D + 8 * fq;
        f32x4 acc = (f32x4){0.f, 0.f, 0.f, 0.f}; float ss = 0.f;
        if (rb != gw) {
#pragma unroll
            for (int kb = 0; kb < 32; ++kb) xw[kb] = *(const u32x4*)(xr + 32 * kb);
            asm volatile("" ::: "memory");
        }
#pragma unroll
        for (int kb = 0; kb < 32; ++kb) {
            f32x4 a0, a1; unpack8(xw[kb], a0, a1);
            const f32x4 ga = *(const LAS f32x4*)(gp + 128 * kb), gb = *(const LAS f32x4*)(gp + 128 * kb + 16);
            ss += (a0[0] * a0[0] + a0[1] * a0[1]) + (a0[2] * a0[2] + a0[3] * a0[3]) + (a1[0] * a1[0] + a1[1] * a1[1]) + (a1[2] * a1[2] + a1[3] * a1[3]);
            const f32x4 y0 = a0 * ga, y1 = a1 * gb;
            const u32x4 hw = pack8(y0, y1); f32x4 h0, h1; unpack8(hw, h0, h1);
            const u32x4 lw = pack8(y0 - h0, y1 - h1);
            *(u32x2*)(hr + 32 * kb) = pack8_fp8(y0, y1);
            const bf16x8 wh = *(const LAS bf16x8*)(whp + 64 * kb), wl = *(const LAS bf16x8*)(whp + P5_WL + 64 * kb);
            const bf16x8 xh = __builtin_bit_cast(bf16x8, hw), xl = __builtin_bit_cast(bf16x8, lw);
            acc = __builtin_amdgcn_mfma_f32_16x16x32_bf16(wh, xh, acc, 0, 0, 0);
            acc = __builtin_amdgcn_mfma_f32_16x16x32_bf16(wh, xl, acc, 0, 0, 0);
            acc = __builtin_amdgcn_mfma_f32_16x16x32_bf16(wl, xh, acc, 0, 0, 0);
        }
        ss += __shfl_xor(ss, 16); ss += __shfl_xor(ss, 32);
        const float rstd = rsqrtf(ss * (1.0f / D) + EPS);
        f32x4 lg = acc * rstd; float mx = fmaxf(fmaxf(lg[0], lg[1]), fmaxf(lg[2], lg[3]));
        mx = fmaxf(mx, __shfl_xor(mx, 16)); mx = fmaxf(mx, __shfl_xor(mx, 32));
        f32x4 e; float sum = 0.f;
#pragma unroll
        for (int r = 0; r < 4; ++r) { e[r] = expf(lg[r] - mx); sum += e[r]; }
        sum += __shfl_xor(sum, 16); sum += __shfl_xor(sum, 32);
        *(f32x4*)(AFF + row * NE + 4 * fq) = e * (1.0f / sum);
        if (fq == 0) RSTD[row] = rstd;
    }
}

__device__ __forceinline__ void p6_topk_item(LAS unsigned char* lds, int item, const float* AFF, const float* RSTD, int* IDX, float* GATEV, float* RS, short* INV, int wave, int lane, int tid) {
    LAS unsigned* hist = (LAS unsigned*)lds; LAS unsigned* sel = hist + 256; LAS unsigned* wtot = hist + 272;
    const int e = item >> 5, b = item & 31;
    unsigned key[4]; float val[4];
    const f32x4 rs4 = *(const f32x4*)(RSTD + (size_t)b * S + 4 * tid);
#pragma unroll
    for (int j = 0; j < 4; ++j) { val[j] = AFF[((size_t)b * S + 4 * tid + j) * NE + e]; key[j] = __float_as_uint(val[j]); }
    unsigned prefix = 0u, krem = CAP;
#pragma unroll 1
    for (int pass = 0; pass < 4; ++pass) {
        const int shift = 24 - 8 * pass;
        if (tid < 256) hist[tid] = 0u;
        __syncthreads();
#pragma unroll
        for (int j = 0; j < 4; ++j) if (pass == 0 || (key[j] >> (shift + 8)) == prefix) __hip_atomic_fetch_add(&hist[(key[j] >> shift) & 255u], 1u, __ATOMIC_RELAXED, __HIP_MEMORY_SCOPE_WORKGROUP);
        __syncthreads();
        if (wave == 0) {
            unsigned c[4];
#pragma unroll
            for (int j = 0; j < 4; ++j) c[j] = hist[4 * lane + j];
            const unsigned tot = c[0] + c[1] + c[2] + c[3]; unsigned sfx = tot;
#pragma unroll
            for (int o = 1; o < 64; o <<= 1) { const unsigned t = __shfl_down(sfx, o); if (lane + o < 64) sfx += t; }
            unsigned cum = sfx - tot;
#pragma unroll
            for (int j = 3; j >= 0; --j) { if (cum < krem && krem <= cum + c[j]) { sel[0] = 4u * lane + j; sel[1] = krem - cum; } cum += c[j]; }
        }
        __syncthreads();
        prefix = (prefix << 8) | sel[0]; krem = sel[1];
    }
    unsigned ngt = 0u, neq = 0u;
#pragma unroll
    for (int j = 0; j < 4; ++j) { ngt += key[j] > prefix; neq += key[j] == prefix; }
    unsigned pk = ngt | (neq << 16), inc = pk;
#pragma unroll
    for (int o = 1; o < 64; o <<= 1) { const unsigned t = __shfl_up(inc, o); if (lane >= o) inc += t; }
    if (lane == 63) wtot[wave] = inc;
    __syncthreads();
    unsigned base = inc - pk;
    for (int w = 0; w < wave; ++w) base += wtot[w];
    unsigned gi = base & 0xffffu, ei = base >> 16; const unsigned ngt_tot = CAP - krem;
#pragma unroll
    for (int j = 0; j < 4; ++j) { int slot = -1;
        if (key[j] > prefix) slot = (int)gi++; else if (key[j] == prefix) { if (ei < krem) slot = (int)(ngt_tot + ei); ++ei; }
        const int tok = b * S + 4 * tid + j; INV[(size_t)tok * NE + e] = (short)slot;
        if (slot >= 0) { const size_t r = (size_t)item * CAP + slot; IDX[r] = tok; GATEV[r] = val[j]; RS[r] = rs4[j]; } }
    __syncthreads();
}

__device__ __forceinline__ void p9_combine(const short* INV, const unsigned char* Y, const bf16* X1B, float* out, int gw, int NGW, int lane) {
    for (int t0 = gw; t0 < T; t0 += 2 * NGW) {
        f32x4 v[2][4]; int myslot[2]; unsigned long long mask[2];
#pragma unroll
        for (int r = 0; r < 2; ++r) { const int t = t0 + r * NGW; const u32x2* xp = (const u32x2*)(X1B + (size_t)t * D) + lane;
#pragma unroll
            for (int j = 0; j < 4; ++j) { const u32x2 w = __builtin_nontemporal_load(xp + 64 * j); v[r][j] = (f32x4){bflo2f(w.x), bfhi2f(w.x), bflo2f(w.y), bfhi2f(w.y)}; }
            myslot[r] = (lane < NE) ? (int)INV[(size_t)t * NE + lane] : -1; }
#pragma unroll
        for (int r = 0; r < 2; ++r) mask[r] = __ballot(myslot[r] >= 0);
        while (mask[0] | mask[1]) {
            unsigned w[2][2][4]; bool has[2][2];
#pragma unroll
            for (int r = 0; r < 2; ++r)
#pragma unroll
                for (int q = 0; q < 2; ++q) { has[r][q] = mask[r] != 0ull;
                    if (has[r][q]) { const int e = __builtin_ctzll(mask[r]); mask[r] &= mask[r] - 1; const int slot = __shfl(myslot[r], e); const int b = (t0 + r * NGW) >> 11;
                        const unsigned* yp = (const unsigned*)(Y + ((size_t)(e * NB + b) * CAP + slot) * D) + lane;
#pragma unroll
                        for (int j = 0; j < 4; ++j) w[r][q][j] = __builtin_nontemporal_load(yp + 64 * j); } }
#pragma unroll
            for (int r = 0; r < 2; ++r)
#pragma unroll
                for (int q = 0; q < 2; ++q) if (has[r][q]) {
#pragma unroll
                    for (int j = 0; j < 4; ++j) { const f32x2 lo = __builtin_amdgcn_cvt_pk_f32_fp8((int)w[r][q][j], false), hi = __builtin_amdgcn_cvt_pk_f32_fp8((int)w[r][q][j], true);
                        v[r][j] += (f32x4){lo[0], lo[1], hi[0], hi[1]} * (1.0f / YSCALE); } }
        }
#pragma unroll
        for (int r = 0; r < 2; ++r) { f32x4* op = (f32x4*)(out + (size_t)(t0 + r * NGW) * D) + lane;
#pragma unroll
            for (int j = 0; j < 4; ++j) __builtin_nontemporal_store(v[r][j], op + 64 * j); }
    }
}

constexpr int LDS_CTL_OFF = 155648, LDS_BYTES = LDS_CTL_OFF + 256;
static_assert(SP_END <= LDS_CTL_OFF && AT_END <= LDS_CTL_OFF && pg::LTAB_OFF + pg::LTAB_BYTES <= LDS_CTL_OFF && LDS_BYTES <= 163840, "LDS map");
constexpr int NPHASE = 10;
#ifndef MK_REV8
#define MK_REV8 1
#endif
#ifndef MK_WGM7
#define MK_WGM7 4
#define MK_WGM8 4
#endif
#ifndef MK_REPEAT
#define MK_REPEAT -1
#endif
struct Args { const float* in[19]; float* out; unsigned char* ws; int ph_lo, ph_hi, li, pad; };
typedef const Args __attribute__((address_space(4))) CArgs;
__global__ void __launch_bounds__(NTHREADS, 2) mk_fwd(Args) {
    extern __shared__ __attribute__((aligned(16))) unsigned char lds_raw[];
    LAS unsigned char* lds = (LAS unsigned char*)lds_raw;
    CArgs* ap0 = (CArgs*)__builtin_amdgcn_kernarg_segment_ptr();
    const int tid = threadIdx.x, lane = tid & 63, wave = __builtin_amdgcn_readfirstlane(tid >> 6);
    const int G = gridDim.x, bid = blockIdx.x;
    const int gw = bid * NWAVES + wave, NGW = G * NWAVES, gtid = bid * NTHREADS + tid, NGT = G * NTHREADS;
    if (tid < 64) ((LAS unsigned*)(lds + LDS_CTL_OFF))[tid] = 0u;
    __syncthreads();
    const int lo = ap0->ph_lo, hi = ap0->ph_hi;
    XcdBarrier bar = xcd_barrier_post((unsigned*)(ap0->ws + WS_CTL) + CW_BAR + ap0->li * XCD_BAR_WORDS, (volatile LAS unsigned*)(lds + LDS_CTL_OFF));
#define IN(k) (lo <= (k) && (k) < hi)
#define SEAM(k) do { if (IN(k) && IN((k) + 1)) xcd_barrier(bar); } while (0)
#define PH CArgs* ap = ap0; asm volatile("" : "+s"(ap)); unsigned char* const ws = ap->ws; (void)ws
#define WSP(T_, off) ((T_*)(ws + (off)))
#define DUP(k, ...) __VA_ARGS__

#define BODY0 { PH; P0Args a{WSP(float, WS_RSTD0), WSP(float, WS_IG1), ap->in[0], ap->in[1], ap->in[2], ap->in[11], ap->in[12], ap->in[13], ap->in[5], ap->in[14], ap->in[15], ap->in[16], ap->in[17], ap->in[18], WSP(bf16, WS_WIN), WSP(bf16, WS_WPROJ), WSP(bf16, WS_WOUT), \
        WSP(bf16, WS_WSP), WSP(bf16, WS_WRH), WSP(bf16, WS_WRL), ws + WS_WGU, ws + WS_WDN, WSP(bf16, WS_H), ws + WS_WIN8, ws + WS_H0F8}; p0_prologue(lds, a, gw, NGW, wave, lane, gtid, NGT); }
#define BODY1 { PH; { pg::Prob g{(const char*)(ws + WS_H), nullptr, (const char*)(ws + WS_WIN), D * 2, 31, 0}; pg::StaticOrder So; So.init(T, 1024, G, bid); \
        EpiInT<false> E{WSP(bf16, WS_UG), WSP(bf16, WS_VG), WSP(bf16, WS_Q), WSP(bf16, WS_K), WSP(bf16, WS_VB), WSP(unsigned short, WS_R), ap->in[3], ap->in[7], ap->in[8], (LAS float*)(lds + pg::LTAB_OFF)}; pg::gemm_phase<EpiInT<false>, false, false>(lds, g, So, E); } \
        { pg::Prob g{(const char*)(ws + WS_H0F8), nullptr, (const char*)(ws + WS_WIN8), D, 31, 0}; pg::StaticOrder So; So.init(T, 2816, G, bid); \
        EpiInT<true> E{WSP(bf16, WS_UG), WSP(bf16, WS_VG), WSP(bf16, WS_Q), WSP(bf16, WS_K), WSP(bf16, WS_VB), WSP(unsigned short, WS_R), ap->in[3], ap->in[7], ap->in[8], (LAS float*)(lds + pg::LTAB_OFF)}; pg::gemm_phase<EpiInT<true>, true, false>(lds, g, So, E); } }
#define BODY2 { PH; p2_mixers(lds, bid, G, WSP(bf16, WS_UG), WSP(bf16, WS_VG), ap->in[4], WSP(bf16, WS_WSP), ap->in[6], WSP(bf16, WS_Q), WSP(bf16, WS_K), WSP(bf16, WS_VB), ap->in[9], ap->in[10], WSP(bf16, WS_AO), wave, lane, tid); }
#define BODY3 { PH; pg::Prob g{(const char*)(ws + WS_AO), nullptr, (const char*)(ws + WS_WPROJ), D * 2, 31, 0}; pg::StaticOrder So; So.init(T, D, G, bid); \
        EpiProj E{WSP(unsigned short, WS_R), WSP(bf16, WS_MG)}; pg::gemm_phase<EpiProj, false, false>(lds, g, So, E); }
#define BODY4 { PH; pg::Prob g{(const char*)(ws + WS_MG), nullptr, (const char*)(ws + WS_WOUT), D * 2, 31, 0}; pg::StaticOrder So; So.init(T, D, G, bid); \
        EpiOut E{WSP(bf16, WS_H), WSP(float, WS_RSTD0), WSP(float, WS_IG1), WSP(bf16, WS_X1B)}; pg::gemm_phase<EpiOut, false, false>(lds, g, So, E); }
#define BODY5 { PH; p5_router(lds, WSP(bf16, WS_X1B), ap->in[14], WSP(bf16, WS_WRH), WSP(bf16, WS_WRL), ws + WS_H, WSP(float, WS_AFF), WSP(float, WS_RSTD), gw, NGW, lane, tid); __syncthreads(); }
#define BODY6 { PH; for (int it = bid; it < NE * NB; it += G) p6_topk_item(lds, it, WSP(float, WS_AFF), WSP(float, WS_RSTD), WSP(int, WS_IDX), WSP(float, WS_GATEV), WSP(float, WS_RS), WSP(short, WS_INV), wave, lane, tid); }
#define BODY7 { PH; pg::Prob g{(const char*)(ws + WS_H), WSP(int, WS_IDX), (const char*)(ws + WS_WGU), D, 5, (size_t)4096 * D}; pg::StaticOrder So; So.init(NSLOT, 4096, G, bid, MK_WGM7); \
        EpiGU E{WSP(float, WS_RS), ws + WS_HID, (const LAS float*)(lds + pg::RSC_OFF)}; pg::gemm_phase<EpiGU, true, true>(lds, g, So, E); }
#define BODY8 { PH; pg::Prob g{(const char*)(ws + WS_HID), nullptr, (const char*)(ws + WS_WDN), FF, 5, (size_t)D * FF}; pg::StaticOrder So; So.init(NSLOT, D, G, bid, MK_WGM8, MK_REV8); \
        EpiDown E{WSP(float, WS_GATEV), ws + WS_Y, (const LAS float*)(lds + pg::RSC_OFF)}; pg::gemm_phase<EpiDown, true, false>(lds, g, So, E); }
#define BODY9 { PH; int t9 = threadIdx.x; asm volatile("" : "+v"(t9)); p9_combine(WSP(short, WS_INV), ws + WS_Y, WSP(bf16, WS_X1B), ap->out, bid * NWAVES + __builtin_amdgcn_readfirstlane(t9 >> 6), NGW, t9 & 63); }
#define RUN(k, BODY) do { if (IN(k)) { BODY if (MK_REPEAT == (k)) { xcd_barrier(bar); BODY } } } while (0)
    RUN(0, BODY0); SEAM(0);
    RUN(1, BODY1);
    SEAM(1);
    RUN(2, BODY2); SEAM(2);
    RUN(3, BODY3); SEAM(3);
    RUN(4, BODY4); SEAM(4);
    RUN(5, BODY5); SEAM(5);
    RUN(6, BODY6); SEAM(6);
    RUN(7, BODY7);
    SEAM(7);
    RUN(8, BODY8); SEAM(8);
    if (IN(9)) BODY9
#undef IN
#undef SEAM
#undef PH
#undef WSP
#undef RUN
}

extern "C" void kernel_launch(void* const* d_in, const int* in_sizes, int n_in, void* d_out, int out_size, void* d_ws, size_t ws_size, hipStream_t stream) {
    static int grid = 0;
    if (grid == 0) {
        if (n_in != 19 || out_size != T * D || ws_size < WS_END) { fprintf(stderr, "kernel_launch: unexpected problem shape (n_in %d, out %d, ws %zu)\n", n_in, out_size, ws_size); grid = -1; return; }
        int dev = 0, cus = 0, per_cu = 0;
        if (hipGetDevice(&dev) != hipSuccess || hipDeviceGetAttribute(&cus, hipDeviceAttributeMultiprocessorCount, dev) != hipSuccess) { grid = -1; return; }
        if (hipFuncSetAttribute((const void*)mk_fwd, hipFuncAttributeMaxDynamicSharedMemorySize, LDS_BYTES) != hipSuccess) { fprintf(stderr, "kernel_launch: hipFuncSetAttribute failed\n"); grid = -1; return; }
        if (hipOccupancyMaxActiveBlocksPerMultiprocessor(&per_cu, (const void*)mk_fwd, NTHREADS, LDS_BYTES) != hipSuccess || per_cu < 1) fprintf(stderr, "kernel_launch: occupancy query reports %d\n", per_cu);
        (void)hipGetLastError();
        if (cus < 256) { fprintf(stderr, "kernel_launch: built for a 256-CU device (%d CUs found); nothing launched\n", cus); grid = -1; return; }
        grid = 256;
    }
    if (grid < 0) return;
    (void)hipMemsetAsync((char*)d_ws + WS_CTL, 0, CTL_ZERO_BYTES, stream);
    Args a{};
    for (int i = 0; i < 19; ++i) a.in[i] = (const float*)d_in[i];
    a.out = (float*)d_out; a.ws = (unsigned char*)d_ws;
    a.ph_lo = 0; a.ph_hi = NPHASE; a.li = 0; a.pad = 0;
    hipLaunchKernelGGL(mk_fwd, dim3(grid), dim3(NTHREADS), LDS_BYTES, stream, a);
}
```

```cpp
#include <hip/hip_runtime.h>
#include <stdint.h>
#include <stdio.h>

#define LAS __attribute__((address_space(3)))
#define GAS __attribute__((address_space(1)))
typedef unsigned short bf16;
typedef short bf16x8 __attribute__((ext_vector_type(8)));
typedef short s16x4 __attribute__((ext_vector_type(4)));
typedef float f32x4 __attribute__((ext_vector_type(4)));
typedef float f32x2 __attribute__((ext_vector_type(2)));
typedef unsigned u32x4 __attribute__((ext_vector_type(4)));
typedef unsigned u32x2 __attribute__((ext_vector_type(2)));

constexpr int NB = 32, S = 2048, D = 1024, T = NB * S;
constexpr int AW = 512, BW = 512, KVW = 128, INC = 3840, NE = 16, FF = 2048, CAP = 256, NSLOT = NE * NB * CAP;
constexpr float EPS = 1e-6f;
constexpr int AOB = 1536;
constexpr float OSC = 16.0f;
constexpr int NWAVES = 8, NTHREADS = 512;

constexpr size_t MiB = 1u << 20;
constexpr size_t WS_CTL = 0, CTL_ZERO_BYTES = 64 * 1024;
constexpr size_t WS_WIN = 1 * MiB, WS_WPROJ = 9 * MiB, WS_WOUT = 11 * MiB, WS_WSP = 13 * MiB, WS_WRH = 13 * MiB + 512 * 1024, WS_WRL = 13 * MiB + 768 * 1024;
constexpr size_t WS_WDN = 14 * MiB, WS_WGU = 46 * MiB;
constexpr size_t WS_H = 206 * MiB, WS_AFF = 334 * MiB, WS_IDX = 338 * MiB, WS_GATEV = 338 * MiB + 512 * 1024, WS_RS = 339 * MiB, WS_RSTD = 339 * MiB + 512 * 1024, WS_RSTD0 = 339 * MiB + 768 * 1024;
constexpr size_t WS_UG = 340 * MiB, WS_VG = 404 * MiB, WS_Q = 468 * MiB, WS_K = 532 * MiB, WS_VB = 548 * MiB, WS_R = 564 * MiB, WS_GB = 692 * MiB, WS_AO = 820 * MiB;
constexpr size_t WS_MG = 340 * MiB, WS_HID = 340 * MiB, WS_INV = 852 * MiB, WS_X1B = 856 * MiB, WS_END = 984 * MiB;
constexpr size_t WS_H0F8 = 692 * MiB, WS_WIN8 = 760 * MiB;
constexpr size_t WS_Y = 596 * MiB;
constexpr float YSCALE = 16.0f;
constexpr float WSCALE = 32.0f;
constexpr size_t WS_IG1 = 512 * 1024;
constexpr int CW_TMO = 0, CW_BAR = 4096;

__device__ __forceinline__ float bf2f(unsigned b) { return __uint_as_float((b & 0xffffu) << 16); }
__device__ __forceinline__ float bfhi2f(unsigned w) { return __uint_as_float(w & 0xffff0000u); }
__device__ __forceinline__ float bflo2f(unsigned w) { return __uint_as_float(w << 16); }
__device__ __forceinline__ bf16 f2bf(float f) { unsigned u = __float_as_uint(f); u += 0x7fffu + ((u >> 16) & 1u); return (bf16)(u >> 16); }
__device__ __forceinline__ unsigned pk2(float lo, float hi) { unsigned r; asm volatile("v_cvt_pk_bf16_f32 %0, %1, %2" : "=v"(r) : "v"(lo), "v"(hi)); return r; }
__device__ __forceinline__ int t5_bucket(int rel) { const int n = rel < 0 ? -rel : rel; const int v = n < 8 ? n : 8 + (n >= 12) + (n >= 16) + (n >= 23) + (n >= 32) + (n >= 46) + (n >= 64) + (n >= 91); return (rel > 0 ? 16 : 0) + v; }
__device__ __forceinline__ float fast_exp(float x) { return __builtin_amdgcn_exp2f(x * 1.4426950408889634f); }
__device__ __forceinline__ float fast_rcp(float x) { return __builtin_amdgcn_rcpf(x); }
__device__ __forceinline__ float min1(float a, float b) { float r; asm("v_min_f32 %0, %1, %2" : "=v"(r) : "v"(a), "v"(b)); return r; }
__device__ __forceinline__ float max1(float a, float b) { float r; asm("v_max_f32 %0, %1, %2" : "=v"(r) : "v"(a), "v"(b)); return r; }
__device__ __forceinline__ float clamp1(float x, float lo, float hi) { return __builtin_amdgcn_fmed3f(x, lo, hi); }
__device__ __forceinline__ float gelu_t(float x) { const float x2 = x * x; const float a = x * (-2.3022081981f - 0.1029432404f * x2); return x * fast_rcp(1.0f + __builtin_amdgcn_exp2f(a)); }

__device__ __forceinline__ int inv_bf16(int L) { return 128 * ((L >> 5) & 1) + 32 * (L >> 6) + 16 * ((L >> 2) & 1) + 4 * ((L >> 3) & 3) + (L & 3); }
__device__ __forceinline__ int inv_f32(int L) { return 128 * ((L >> 5) & 1) + 32 * (L >> 6) + 16 * ((L >> 4) & 1) + 4 * ((L >> 2) & 3) + (L & 3); }
__device__ __forceinline__ int inv_pair(int which, int L) { return 128 * which + 32 * (L >> 5) + 16 * ((L >> 2) & 1) + 4 * ((L >> 3) & 3) + (L & 3); }

#define XB_TMO      128
#define XB_XCNT(j)  (256  + 64 * (j))
#define XB_XSUB(j)  (1280 + 64 * (j))
#define XB_XGEN(j)  (2304 + 64 * (j))
#define XB_TOP      3328
#define XB_TOPGEN   3392
#define XCD_BAR_WORDS 3456
#define XB_SPIN_CAP (1u << 18)
__device__ __forceinline__ unsigned xb_ld(unsigned* p)              { return __hip_atomic_load(p, __ATOMIC_RELAXED, __HIP_MEMORY_SCOPE_AGENT); }
__device__ __forceinline__ unsigned xb_add(unsigned* p, unsigned v) { return __hip_atomic_fetch_add(p, v, __ATOMIC_RELAXED, __HIP_MEMORY_SCOPE_AGENT); }
__device__ __forceinline__ unsigned xb_xcc_id() { return (unsigned)__builtin_amdgcn_s_getreg((3 << 11) | 20) & 0xFu; }
#define XB_SPIN(cond, bar) do { unsigned _sp = 0; while (cond) { __builtin_amdgcn_s_sleep(1); \
    if ((++_sp & 255u) == 0u) { if (xb_ld(&(bar)[XB_TMO])) break; if (_sp > XB_SPIN_CAP) { atomicAdd(&(bar)[XB_TMO], 1u); break; } } } } while (0)
struct XcdBarrier { unsigned* bar; unsigned x; volatile LAS unsigned* st; };
__device__ __forceinline__ XcdBarrier xcd_barrier_post(unsigned* bar, volatile LAS unsigned* st) {
    XcdBarrier b; b.bar = bar; b.x = xb_xcc_id(); b.st = st;
    if (threadIdx.x == 0) (void)xb_add(&bar[XB_XCNT(b.x)], 1u);
    return b;
}
__device__ __forceinline__ void xcd_barrier_complete(unsigned* bar, unsigned x, unsigned& nloc, unsigned& nx) {
    const unsigned G = gridDim.x * gridDim.y * gridDim.z;
    unsigned sum, cnt, mine, sp = 0u;
    for (;;) {
        sum = 0u; cnt = 0u; mine = 0u;
#pragma unroll
        for (unsigned j = 0; j < 16; ++j) { const unsigned c = xb_ld(&bar[XB_XCNT(j)]); sum += c; cnt += (c > 0u) ? 1u : 0u; mine = (j == x) ? c : mine; }
        if (sum == G) break;
        __builtin_amdgcn_s_sleep(1);
        if ((++sp & 255u) == 0u) { if (xb_ld(&bar[XB_TMO])) break; if (sp > XB_SPIN_CAP) { atomicAdd(&bar[XB_TMO], 1u); break; } }
    }
    nloc = mine > 0u ? mine : 1u; nx = cnt > 0u ? cnt : 1u;
}
__device__ __forceinline__ void xcd_barrier(const XcdBarrier& b) {
    asm volatile("s_waitcnt vmcnt(0)" ::: "memory");
    __syncthreads();
    if (threadIdx.x == 0) {
        unsigned* bar = b.bar;
        __builtin_amdgcn_s_waitcnt(0);
        unsigned nloc = b.st[0], nx = b.st[1];
        if (nloc == 0u) { xcd_barrier_complete(bar, b.x, nloc, nx); b.st[0] = nloc; b.st[1] = nx; }
        const unsigned old = xb_add(&bar[XB_XSUB(b.x)], 1u);
        const unsigned gen = old / nloc;
        if (old + 1u == (gen + 1u) * nloc) {
            __builtin_amdgcn_fence(__ATOMIC_RELEASE, "agent");
            asm volatile("s_waitcnt vmcnt(0)" ::: "memory");
            const unsigned og = xb_add(&bar[XB_TOP], 1u);
            const unsigned tg = og / nx;
            if (og + 1u == (tg + 1u) * nx) xb_add(&bar[XB_TOPGEN], 1u);
            else XB_SPIN(xb_ld(&bar[XB_TOPGEN]) == tg, bar);
            __builtin_amdgcn_fence(__ATOMIC_ACQUIRE, "agent");
            xb_add(&bar[XB_XGEN(b.x)], 1u);
            asm volatile("s_waitcnt vmcnt(0)" ::: "memory");
        } else {
            XB_SPIN(xb_ld(&bar[XB_XGEN(b.x)]) == gen, bar);
            __builtin_amdgcn_fence(__ATOMIC_ACQUIRE, "agent");
            asm volatile("s_waitcnt vmcnt(0)" ::: "memory");
        }
    }
    __syncthreads();
}

namespace pg {
typedef int i32x4 __attribute__((ext_vector_type(4)));
typedef int i32x8 __attribute__((ext_vector_type(8)));
typedef double f64x2 __attribute__((ext_vector_type(2)));
constexpr int BM = 256, BK = 64, HALF = 128, HTB = HALF * BK * 2, STAGE_BYTES = 8 * HTB, NXCD = 8, WGM = 4;
__device__ __forceinline__ int lds_byte(int r, int c) { const int st = (r >> 4) * 2 + (c >> 5), rr = r & 15, cc = c & 31, ob = rr * 64 + cc * 2; return st * 1024 + (ob ^ (((ob >> 9) & 1) << 5)); }
__device__ __forceinline__ void stage_rc(int b, int& R, int& C) { const int st = b / 1024, sb = b % 1024, swz = sb ^ (((sb >> 9) & 1) << 5); R = (st >> 1) * 16 + swz / 64; C = (st & 1) * 32 + (swz % 64) / 2; }
struct Unit { int pm, pn; };
struct StaticOrder {
    int nM, nN, nwg, G, c, wgm, rev;
    __device__ __forceinline__ void init(int M, int N, int G_, int c_, int wgm_ = WGM, int rev_ = 0) { nM = M / BM; nN = N / BM; nwg = nM * nN; G = G_; c = c_; wgm = wgm_; rev = rev_; }
    __device__ __forceinline__ bool next(int i, Unit& u) const {
        const long L = (long)i * G + c; if (L >= nwg) return false;
        int wgid = (int)L; { const int q = nwg / NXCD, r = nwg % NXCD, xcd = wgid % NXCD, off = wgid / NXCD; wgid = (xcd < r ? xcd * (q + 1) : r * (q + 1) + (xcd - r) * q) + off; }
        const int nig = wgm * nN, gid = wgid / nig, fm = gid * wgm, gsz = (nM - fm) < wgm ? (nM - fm) : wgm;
        u.pm = fm + ((wgid % nig) % gsz); u.pn = (wgid % nig) / gsz; if (rev) u.pm = nM - 1 - u.pm; return true;
    }
};
struct Prob { const char* A; const int* idx; const char* Bt; int KB; int gshift; size_t gstride; };
constexpr int LTAB_OFF = STAGE_BYTES, LTAB_BYTES = 32 * 256 * 2, RSC_OFF = LTAB_OFF + LTAB_BYTES;

__device__ __forceinline__ const char* uni(const char* p) { const unsigned long long v = (unsigned long long)p; const unsigned lo = __builtin_amdgcn_readfirstlane((unsigned)v), hi = __builtin_amdgcn_readfirstlane((unsigned)(v >> 32)); return (const char*)(((unsigned long long)hi << 32) | lo); }
template <class Epi, int FP8, bool GATHER, class Sched = StaticOrder>
__device__ __forceinline__ void gemm_phase(LAS unsigned char* lds, const Prob g, const Sched& S, const Epi& E) {
    const int tid = threadIdx.x, wid = __builtin_amdgcn_readfirstlane(tid >> 6), lane = tid & 63, wr = wid >> 2, wc = wid & 3, fr = lane & 15, fq = lane >> 4;
    const int KB = g.KB, nt = KB / (BK * 2);
    int R2[2], C2[2]; unsigned voffB[2];
#pragma unroll
    for (int i = 0; i < 2; ++i) { stage_rc(tid * 16 + i * 8192, R2[i], C2[i]); voffB[i] = (unsigned)(R2[i] * KB + C2[i] * 2); }
    const size_t kstep = (size_t)(BK * 2);
    const size_t hstep = (size_t)HALF * KB;
    const size_t tstep = 2 * hstep;
    const unsigned rowb = (unsigned)KB;
    const unsigned ldsw = (unsigned)wid * 1024u;
    const int aoff = lds_byte(wr * 64 + fr, fq * 8), boff = lds_byte(wc * 32 + fr, fq * 8);
#define PG_SA(b, h) (((b) * 2 + (h)) * HTB)
#define PG_SB(b, h) ((4 + (b) * 2 + (h)) * HTB)
#define PG_STAGE(bufoff, gbase, voff) do { _Pragma("unroll") for (int _i = 0; _i < 2; ++_i) \
        __builtin_amdgcn_global_load_lds((const unsigned*)(uni((const char*)(gbase)) + (voff)[_i]), (LAS unsigned*)(lds + (bufoff) + ldsw + _i * 8192), 16, 0, 0); } while (0)
#define PG_LD16(base, off) (*(const LAS i32x4*)(lds + (base) + (off)))
#define PG_CAT2(lo, hi) __builtin_shufflevector((lo), (hi), 0, 1, 2, 3, 4, 5, 6, 7)
#define PG_LDA(dst, b, h) do { _Pragma("unroll") for (int m = 0; m < 4; ++m) dst[m] = PG_CAT2(PG_LD16(la, PG_SA(b, h) + m * 2048), PG_LD16(la, PG_SA(b, h) + m * 2048 + 1024)); } while (0)
#define PG_LDB(dst, b, h) do { _Pragma("unroll") for (int n = 0; n < 2; ++n) dst[n] = PG_CAT2(PG_LD16(lb, PG_SB(b, h) - 65536 + n * 2048), PG_LD16(lb, PG_SB(b, h) - 65536 + n * 2048 + 1024)); } while (0)
#define PG_LO(x) __builtin_bit_cast(bf16x8, __builtin_shufflevector((x), (x), 0, 1, 2, 3))
#define PG_HI(x) __builtin_bit_cast(bf16x8, __builtin_shufflevector((x), (x), 4, 5, 6, 7))
#define PG_MMA8(ai, bj, At, Bt) do { _Pragma("unroll") for (int m = 0; m < 4; ++m) _Pragma("unroll") for (int n = 0; n < 2; ++n) \
        acc[ai][bj][m][n] = __builtin_amdgcn_mfma_scale_f32_16x16x128_f8f6f4(Bt[n], At[m], acc[ai][bj][m][n], 0, 0, 0, 0, 0, 0); } while (0)
#define PG_MMA16(ai, bj, At, Bt) do { _Pragma("unroll") for (int m = 0; m < 4; ++m) _Pragma("unroll") for (int n = 0; n < 2; ++n) { \
        acc[ai][bj][m][n] = __builtin_amdgcn_mfma_f32_16x16x32_bf16(PG_LO(Bt[n]), PG_LO(At[m]), acc[ai][bj][m][n], 0, 0, 0); \
        acc[ai][bj][m][n] = __builtin_amdgcn_mfma_f32_16x16x32_bf16(PG_HI(Bt[n]), PG_HI(At[m]), acc[ai][bj][m][n], 0, 0, 0); } } while (0)
#define PG_MMA(ai, bj, At, Bt) do { __builtin_amdgcn_s_setprio(1); \
        if constexpr (FP8 == 1) PG_MMA8(ai, bj, At, Bt); else if constexpr (FP8 == 0) PG_MMA16(ai, bj, At, Bt); else { if constexpr (f8t) PG_MMA8(ai, bj, At, Bt); else PG_MMA16(ai, bj, At, Bt); } \
        __builtin_amdgcn_s_setprio(0); } while (0)
#define PG_WAIT_V(n) asm volatile("s_waitcnt vmcnt(" #n ")" ::: "memory")
#define PG_WAIT_L(n) asm volatile("s_waitcnt lgkmcnt(" #n ")" ::: "memory")
#define PG_BAR __builtin_amdgcn_s_barrier()
#define PG_SCHED __builtin_amdgcn_sched_barrier(0)
#define PG_AOFFS(dst, ord) do { _Pragma("unroll") for (int _h = 0; _h < 2; ++_h) _Pragma("unroll") for (int _i = 0; _i < 2; ++_i) \
        dst[_h][_i] = (unsigned)ltab[(ord) * 256 + _h * HALF + R2[_i]] * rowb + (unsigned)C2[_i] * 2u; } while (0)
    const LAS unsigned short* ltab = (const LAS unsigned short*)(lds + LTAB_OFF);
    if constexpr (GATHER) {
        Unit u0; for (int i = 0; i < 32 && S.next(i, u0); ++i) { if (tid < 256) ((LAS unsigned short*)(lds + LTAB_OFF))[i * 256 + tid] = (unsigned short)g.idx[u0.pm * BM + tid]; }
        __syncthreads();
    }
    if constexpr (Epi::PREP) { E.prep(tid); __syncthreads(); }
    Unit cur, nxt; int ui = 0;
    if (!S.next(0, cur)) return;

    f32x4 acc[2][2][4][2];
#define PG_ACC_INIT(u) do { if constexpr (Epi::INIT) { int t2 = tid; asm volatile("" : "+v"(t2)); E.init(acc, u, wr, wc, t2 & 15, (t2 & 63) >> 4); \
        _Pragma("unroll") for (int a = 0; a < 2; ++a) _Pragma("unroll") for (int b = 0; b < 2; ++b) _Pragma("unroll") for (int m = 0; m < 4; ++m) _Pragma("unroll") for (int n = 0; n < 2; ++n) asm volatile("" : "+v"(acc[a][b][m][n])); } \
      else { _Pragma("unroll") for (int a = 0; a < 2; ++a) _Pragma("unroll") for (int b = 0; b < 2; ++b) _Pragma("unroll") for (int m = 0; m < 4; ++m) _Pragma("unroll") for (int n = 0; n < 2; ++n) { \
            double z0_, z1_; asm volatile("v_mov_b64 %0, 0" : "=v"(z0_)); asm volatile("v_mov_b64 %0, 0" : "=v"(z1_)); acc[a][b][m][n] = __builtin_bit_cast(f32x4, (f64x2){z0_, z1_}); } } } while (0)
    PG_ACC_INIT(cur);
    i32x8 At[4], B0[2], B1[2];
    unsigned vA[2][2], vN[2][2];
    if constexpr (GATHER) { PG_AOFFS(vA, 0); }
    const char* cA = GATHER ? g.A : g.A + (size_t)cur.pm * tstep;
    const char* cB = g.Bt + (size_t)(cur.pm >> g.gshift) * g.gstride + (size_t)cur.pn * tstep;
#define PG_STAGE_A(bufoff, ptr, h) do { if constexpr (GATHER) { PG_STAGE(bufoff, ptr, vA[h]); } else { PG_STAGE(bufoff, (ptr) + (h) * hstep, voffB); } } while (0)
    PG_STAGE(PG_SB(0, 0), cB, voffB); PG_STAGE(PG_SB(0, 1), cB + hstep, voffB); PG_STAGE_A(PG_SA(0, 0), cA, 0); PG_STAGE_A(PG_SA(0, 1), cA, 1);
    if (wr == 1) PG_BAR;
    PG_WAIT_V(2); PG_BAR;
    PG_STAGE(PG_SB(1, 0), cB + kstep, voffB); PG_STAGE_A(PG_SA(1, 0), cA + kstep, 0); PG_STAGE(PG_SB(1, 1), cB + hstep + kstep, voffB);
    PG_WAIT_V(6); PG_BAR;
    for (;;) {
        const bool has_next = S.next(ui + 1, nxt);
        if constexpr (GATHER) { if (has_next) { PG_AOFFS(vN, ui + 1); } else {
#pragma unroll
            for (int _h = 0; _h < 2; ++_h)
#pragma unroll
                for (int _i = 0; _i < 2; ++_i) vN[_h][_i] = vA[_h][_i]; } }
        const char* nA = GATHER ? g.A : (has_next ? g.A + (size_t)nxt.pm * tstep : cA);
        const char* nB = has_next ? g.Bt + (size_t)(nxt.pm >> g.gshift) * g.gstride + (size_t)nxt.pn * tstep : cB;
#define PG_TRIP(F8T_) do { \
            const bool last = (t == nt - 2); constexpr bool f8t = (F8T_); \
            unsigned la = (unsigned)aoff, lb = (unsigned)boff + 65536u; asm volatile("" : "+v"(la), "+v"(lb)); \
            asm volatile("" : "+v"(voffB[0]), "+v"(voffB[1])); \
            if constexpr (GATHER) asm volatile("" : "+v"(vA[0][0]), "+v"(vA[0][1]), "+v"(vA[1][0]), "+v"(vA[1][1])); \
            if constexpr (Epi::MID) { if (t == Epi::MIDT) { int t2 = tid; asm volatile("" : "+v"(t2)); E.mid(acc, cur, wr, wc, t2 & 15, (t2 & 63) >> 4); } } \
            const char* a1 = cA + (size_t)(t + 1) * kstep; \
            const char* a2 = last ? nA : cA + (size_t)(t + 2) * kstep; const char* b2 = last ? nB : cB + (size_t)(t + 2) * kstep; \
            const char* a3 = a2 + kstep; const char* b3 = b2 + kstep; \
 \
            PG_LDB(B0, 0, 0); PG_LDB(B1, 0, 1); PG_SCHED; PG_LDA(At, 0, 0); PG_STAGE_A(PG_SA(1, 1), a1, 1); \
            if constexpr (GATHER) { if (last) { \
_Pragma("unroll") \
                for (int _h = 0; _h < 2; ++_h) \
_Pragma("unroll") \
                    for (int _i = 0; _i < 2; ++_i) vA[_h][_i] = vN[_h][_i]; } } \
            PG_WAIT_V(8); PG_WAIT_L(0); PG_BAR; PG_MMA(0, 0, At, B0); PG_MMA(0, 1, At, B1); PG_BAR; PG_SCHED; \
 \
            PG_LDA(At, 0, 1); PG_STAGE(PG_SB(0, 0), b2, voffB); PG_STAGE(PG_SB(0, 1), b2 + hstep, voffB); PG_STAGE_A(PG_SA(0, 0), a2, 0); \
            PG_WAIT_V(8); PG_WAIT_L(0); PG_BAR; PG_MMA(1, 0, At, B0); PG_MMA(1, 1, At, B1); PG_BAR; PG_SCHED; \
 \
            if constexpr (Epi::RSC) { if (last) { const float* rp = E.rsc() + cur.pm * BM + (wid & 3) * 64 + (tid & 63); __builtin_amdgcn_global_load_lds((const unsigned*)rp, (LAS unsigned*)(lds + RSC_OFF + wid * 256), 4, 0, 0); } } \
            PG_LDB(B0, 1, 0); PG_LDB(B1, 1, 1); PG_SCHED; PG_LDA(At, 1, 0); PG_STAGE_A(PG_SA(0, 1), a2, 1); \
            if constexpr (Epi::RSC) { if (last) PG_WAIT_V(9); else PG_WAIT_V(8); } else PG_WAIT_V(8); \
            PG_WAIT_L(0); PG_BAR; PG_MMA(0, 0, At, B0); PG_MMA(0, 1, At, B1); PG_BAR; PG_SCHED; \
 \
            PG_LDA(At, 1, 1); PG_STAGE(PG_SB(1, 0), b3, voffB); PG_STAGE(PG_SB(1, 1), b3 + hstep, voffB); PG_STAGE_A(PG_SA(1, 0), a3, 0); \
            PG_WAIT_V(8); PG_WAIT_L(0); PG_BAR; PG_MMA(1, 0, At, B0); PG_MMA(1, 1, At, B1); PG_BAR; PG_SCHED; \
        } while (0)
        if constexpr (FP8 == 2) {
#pragma unroll 1
            for (int t = 0; t < Epi::MIDT; t += 2) PG_TRIP(false);
#pragma unroll 1
            for (int t = Epi::MIDT; t < nt; t += 2) PG_TRIP(true);
        } else {
#pragma unroll 1
            for (int t = 0; t < nt; t += 2) PG_TRIP(false);
        }
        if (wr == 0) PG_BAR;
        { int t2 = tid; Unit cu2 = cur; asm volatile("" : "+v"(t2), "+s"(cu2.pm), "+s"(cu2.pn)); E(acc, cu2, wr, wc, t2 & 15, (t2 & 63) >> 4); }
        if (!has_next) break;
        PG_ACC_INIT(nxt);
        cur = nxt; cA = nA; cB = nB; ++ui;
        if (wr == 1) PG_BAR;
    }
    PG_WAIT_V(0);
    PG_BAR;
#undef PG_SA
#undef PG_SB
#undef PG_STAGE
#undef PG_LDA
#undef PG_LDB
#undef PG_MMA
#undef PG_TRIP
#undef PG_MMA8
#undef PG_MMA16
#undef PG_LD16
#undef PG_CAT2
#undef PG_LO
#undef PG_HI
#undef PG_WAIT_V
#undef PG_WAIT_L
#undef PG_BAR
#undef PG_SCHED
#undef PG_AOFFS
#undef PG_ACC_INIT
#undef PG_STAGE_A
}
}

typedef f32x4 AccT[2][2][4][2];
__device__ __forceinline__ u32x2 pack8_fp8(const f32x4 a, const f32x4 b) { int w0 = 0, w1 = 0; w0 = __builtin_amdgcn_cvt_pk_fp8_f32(a[0], a[1], w0, false); w0 = __builtin_amdgcn_cvt_pk_fp8_f32(a[2], a[3], w0, true);
    w1 = __builtin_amdgcn_cvt_pk_fp8_f32(b[0], b[1], w1, false); w1 = __builtin_amdgcn_cvt_pk_fp8_f32(b[2], b[3], w1, true); return (u32x2){(unsigned)w0, (unsigned)w1}; }
__device__ __forceinline__ u32x4 pack8(const f32x4 a, const f32x4 b) { u32x4 w; w.x = pk2(a[0], a[1]); w.y = pk2(a[2], a[3]); w.z = pk2(b[0], b[1]); w.w = pk2(b[2], b[3]); return w; }
__device__ __forceinline__ void unpack8(const u32x4 w, f32x4& a, f32x4& b) { a = (f32x4){bflo2f(w.x), bfhi2f(w.x), bflo2f(w.y), bfhi2f(w.y)}; b = (f32x4){bflo2f(w.z), bfhi2f(w.z), bflo2f(w.w), bfhi2f(w.w)}; }

__device__ __forceinline__ f32x4 inv1pexp2(const f32x4 e) { f32x4 d;
#pragma unroll
    for (int j = 0; j < 4; ++j) d[j] = __builtin_amdgcn_exp2f(min1(e[j], 60.0f));
    d = d + 1.0f;
    const f32x2 dlo = __builtin_shufflevector(d, d, 0, 1), dhi = __builtin_shufflevector(d, d, 2, 3), p = dlo * dhi;
    const f32x2 r = (f32x2){fast_rcp(p[0]), fast_rcp(p[1])};
    const f32x2 ilo = r * dhi, ihi = r * dlo;
    return __builtin_shufflevector(ilo, ihi, 0, 1, 2, 3); }
__device__ __forceinline__ f32x4 gelu4(const f32x4 x) { const f32x4 x2 = x * x; const f32x4 c = x2 * -0.1029432404f + -2.3022081981f; return x * inv1pexp2(x * c); }
template <bool F8> struct EpiInT {
    static constexpr bool MID = false, INIT = false, RSC = false, PREP = true;
    static constexpr float ASC = F8 ? 1.0f / WSCALE : 1.0f;
    bf16 *UG, *VG, *Q, *KB, *VB; unsigned short* G8; const float *bgate, *qg, *kg; LAS float* PL;
    __device__ __forceinline__ void prep(int tid) const {
        for (int i = tid; i < 2 * D / 4; i += NTHREADS) *(LAS f32x4*)(PL + 4 * i) = *(const f32x4*)(bgate + 4 * i);
        if (tid < 16) *(LAS f32x4*)(PL + 2 * D + 4 * tid) = *(const f32x4*)(qg + 4 * tid);
        else if (tid < 32) *(LAS f32x4*)(PL + 2 * D + 4 * tid) = *(const f32x4*)(kg + 4 * (tid - 16));
    }
    __device__ __forceinline__ void operator()(const AccT& acc, const pg::Unit& u, int wr, int wc, int fr, int fq) const {
        const int row0 = u.pm * 256 + wr * 64 + fr, pn = u.pn + (F8 ? 4 : 0);
        if (pn < 4) {
            bf16* base = (pn < 2 ? UG : VG) + (pn & 1) * 256 + 64 * wc + 8 * fq;
#pragma unroll
            for (int ai = 0; ai < 2; ++ai)
#pragma unroll
                for (int m = 0; m < 4; ++m) { bf16* rowp = base + (size_t)(row0 + ai * 128 + m * 16) * AW;
#pragma unroll
                    for (int bj = 0; bj < 2; ++bj) __builtin_nontemporal_store(pack8(gelu4(acc[ai][bj][m][0]), gelu4(acc[ai][bj][m][1])), (u32x4*)(rowp + 32 * bj)); }
        } else if (pn < 7) {
            const bool isq = pn < 6, norm = isq || wc < 2;
            const LAS float* gp = PL + 2 * D + (isq ? 0 : 64); const float sc = isq ? 0.125f * 1.4426950408889634f : 1.0f;
            f32x4 gv[2][2];
#pragma unroll
            for (int bj = 0; bj < 2; ++bj)
#pragma unroll
                for (int n = 0; n < 2; ++n) gv[bj][n] = *(const LAS f32x4*)(gp + 32 * bj + 8 * fq + 4 * n) * sc;
            bf16* base; int ld;
            if (isq) { base = Q + (pn - 4) * 256 + 64 * wc + 8 * fq; ld = BW; }
            else if (wc < 2) { base = KB + 64 * wc + 8 * fq; ld = KVW; }
            else { base = VB + 64 * (wc - 2) + 8 * fq; ld = KVW; }
#pragma unroll
            for (int ai = 0; ai < 2; ++ai)
#pragma unroll
                for (int m = 0; m < 4; ++m) { bf16* rowp = base + (size_t)(row0 + ai * 128 + m * 16) * ld;
                    float ss = 0.f;
#pragma unroll
                    for (int bj = 0; bj < 2; ++bj)
#pragma unroll
                        for (int n = 0; n < 2; ++n) { const f32x4 x = acc[ai][bj][m][n] * ASC; ss += (x[0] * x[0] + x[1] * x[1]) + (x[2] * x[2] + x[3] * x[3]); }
                    ss += __shfl_xor(ss, 16); ss += __shfl_xor(ss, 32);
                    const float rstd = norm ? rsqrtf(ss * (1.0f / 64.0f) + EPS) : 1.0f;
#pragma unroll
                    for (int bj = 0; bj < 2; ++bj) { f32x4 v0 = acc[ai][bj][m][0] * ASC, v1 = acc[ai][bj][m][1] * ASC;
                        if (norm) { v0 = v0 * rstd * gv[bj][0]; v1 = v1 * rstd * gv[bj][1]; }
                        __builtin_nontemporal_store(pack8(v0, v1), (u32x4*)(rowp + 32 * bj)); } }
        } else {
            const int c0 = 128 * (pn - 7) + 32 * wc + 8 * fq;
            f32x4 ba[2], bb[2];
#pragma unroll
            for (int n = 0; n < 2; ++n) { ba[n] = *(const LAS f32x4*)(PL + c0 + 4 * n) * -1.4426950408889634f; bb[n] = *(const LAS f32x4*)(PL + D + c0 + 4 * n) * -1.4426950408889634f; }
#pragma unroll
            for (int ai = 0; ai < 2; ++ai)
#pragma unroll
                for (int m = 0; m < 4; ++m) { const size_t ro = (size_t)(row0 + ai * 128 + m * 16) * D + c0;
                    unsigned wd[4];
#pragma unroll
                    for (int n = 0; n < 2; ++n) { f32x4 ea = acc[ai][0][m][n] * (-1.4426950408889634f * ASC) + ba[n], eb = acc[ai][1][m][n] * (-1.4426950408889634f * ASC) + bb[n], da, db;
#pragma unroll
                        for (int j = 0; j < 4; ++j) { da[j] = __builtin_amdgcn_exp2f(min1(ea[j], 43.0f)); db[j] = __builtin_amdgcn_exp2f(min1(eb[j], 43.0f)); }
                        da = da + 1.0f; db = db + 1.0f;
                        const f32x4 p = da * db; f32x4 r;
#pragma unroll
                        for (int j = 0; j < 4; ++j) r[j] = fast_rcp(p[j]);
                        r = r * 255.0f;
                        const f32x4 qa = db * r + 0.5f; f32x4 qb = da * r + 0.5f;
#pragma unroll
                        for (int j = 0; j < 4; ++j) qb[j] = max1(qb[j], 1.0f);
#pragma unroll
                        for (int k = 0; k < 2; ++k) { unsigned w_ = 0u;
                            w_ = __builtin_amdgcn_cvt_pk_u8_f32(qa[2 * k], 0u, w_); w_ = __builtin_amdgcn_cvt_pk_u8_f32(qb[2 * k], 1u, w_);
                            w_ = __builtin_amdgcn_cvt_pk_u8_f32(qa[2 * k + 1], 2u, w_); w_ = __builtin_amdgcn_cvt_pk_u8_f32(qb[2 * k + 1], 3u, w_); wd[2 * n + k] = w_; } }
                    u32x4 w; w.x = wd[0]; w.y = wd[1]; w.z = wd[2]; w.w = wd[3];
                    __builtin_nontemporal_store(w, (u32x4*)(G8 + ro)); }
        }
    }
};
struct EpiProj {
    static constexpr bool MID = true, INIT = false, RSC = false, PREP = false;
    static constexpr int MIDT = 8;
    static constexpr float F8S = OSC * WSCALE;
    const unsigned short* G8; bf16* MG;
    __device__ __forceinline__ void mid(AccT& acc, const pg::Unit& u, int wr, int wc, int fr, int fq) const {
        unsigned off = (unsigned)((wr * 64 + fr) * D + 64 * wc + 8 * fq) * 2u; asm volatile("" : "+v"(off));
        const char* base = (const char*)G8 + ((size_t)u.pm * 256 * D + (size_t)u.pn * 256) * 2;
#pragma unroll
        for (int ai = 0; ai < 2; ++ai) {
#pragma unroll
            for (int m = 0; m < 4; ++m) {
#pragma unroll
                for (int bj = 0; bj < 2; ++bj) { const u32x4 w = *(const u32x4*)(base + (off + (unsigned)(((ai * 128 + m * 16) * D + 32 * bj) * 2)));
                    const unsigned ww[4] = {w.x, w.y, w.z, w.w}; f32x4 r0, r1;
#pragma unroll
                    for (int k = 0; k < 4; ++k) { const float qa0 = (float)(ww[k] & 0xffu), qb0 = (float)((ww[k] >> 8) & 0xffu), qa1 = (float)((ww[k] >> 16) & 0xffu), qb1 = (float)(ww[k] >> 24);
                        const float rr = fast_rcp(qb0 * qb1) * F8S; const float v0 = qa0 * (rr * qb1), v1 = qa1 * (rr * qb0);
                        if (k < 2) { r0[2 * k] = v0; r0[2 * k + 1] = v1; } else { r1[2 * (k - 2)] = v0; r1[2 * (k - 2) + 1] = v1; } }
                    acc[ai][bj][m][0] *= r0; acc[ai][bj][m][1] *= r1; } }
        }
    }
    __device__ __forceinline__ void operator()(const AccT& acc, const pg::Unit& u, int wr, int wc, int fr, int fq) const {
        const int row0 = u.pm * 256 + wr * 64 + fr, col0 = u.pn * 256 + 64 * wc + 8 * fq;
#pragma unroll
        for (int ai = 0; ai < 2; ++ai)
#pragma unroll
            for (int m = 0; m < 4; ++m) { const size_t ro = (size_t)(row0 + ai * 128 + m * 16) * D + col0;
#pragma unroll
                for (int bj = 0; bj < 2; ++bj) { const u32x4 w = *(const u32x4*)(G8 + ro + 32 * bj); const unsigned ww[4] = {w.x, w.y, w.z, w.w}; f32x4 g0, g1;
#pragma unroll
                    for (int k = 0; k < 4; ++k) { const float b0 = (float)((ww[k] >> 8) & 0xffu) * (1.0f / (255.0f * F8S)), b1 = (float)(ww[k] >> 24) * (1.0f / (255.0f * F8S));
                        if (k < 2) { g0[2 * k] = b0; g0[2 * k + 1] = b1; } else { g1[2 * (k - 2)] = b0; g1[2 * (k - 2) + 1] = b1; } }
                    *(u32x4*)(MG + ro + 32 * bj) = pack8(acc[ai][bj][m][0] * g0, acc[ai][bj][m][1] * g1); } }
    }
};
struct EpiOut {
    static constexpr bool MID = false, INIT = true, RSC = false, PREP = false;
    const bf16* H0; const float* IRS0; const float* IG1; bf16* X1B;
    __device__ __forceinline__ void init(AccT& acc, const pg::Unit& u, int wr, int wc, int fr, int fq) const {
        const int row0 = u.pm * 256 + wr * 64 + fr, col0 = u.pn * 256 + 64 * wc + 8 * fq;
        f32x4 ig[2][2];
#pragma unroll
        for (int bj = 0; bj < 2; ++bj)
#pragma unroll
            for (int n = 0; n < 2; ++n) ig[bj][n] = *(const f32x4*)(IG1 + col0 + 32 * bj + 4 * n);
#pragma unroll
        for (int ai = 0; ai < 2; ++ai)
#pragma unroll
            for (int m = 0; m < 4; ++m) { const int row = row0 + ai * 128 + m * 16; const size_t ro = (size_t)row * D + col0; const float ir = IRS0[row];
#pragma unroll
                for (int bj = 0; bj < 2; ++bj) { f32x4 a, b; unpack8(*(const u32x4*)(H0 + ro + 32 * bj), a, b); acc[ai][bj][m][0] = a * ir * ig[bj][0]; acc[ai][bj][m][1] = b * ir * ig[bj][1]; } }
    }
    __device__ __forceinline__ void operator()(const AccT& acc, const pg::Unit& u, int wr, int wc, int fr, int fq) const {
        const int row0 = u.pm * 256 + wr * 64 + fr, col0 = u.pn * 256 + 64 * wc + 8 * fq;
#pragma unroll
        for (int ai = 0; ai < 2; ++ai)
#pragma unroll
            for (int m = 0; m < 4; ++m) { const size_t ro = (size_t)(row0 + ai * 128 + m * 16) * D + col0;
#pragma unroll
                for (int bj = 0; bj < 2; ++bj) *(u32x4*)(X1B + ro + 32 * bj) = pack8(acc[ai][bj][m][0], acc[ai][bj][m][1]); }
    }
};
struct EpiGU {
    static constexpr bool MID = false, INIT = false, RSC = true, PREP = false;
    const float* RS; unsigned char* HID; const LAS float* RSL;
    __device__ __forceinline__ const float* rsc() const { return RS; }
    __device__ __forceinline__ void operator()(const AccT& acc, const pg::Unit& u, int wr, int wc, int fr, int fq) const {
        const int row0 = u.pm * 256 + wr * 64 + fr, col0 = u.pn * 128 + 32 * wc + 8 * fq;
#pragma unroll
        for (int ai = 0; ai < 2; ++ai)
#pragma unroll
            for (int m = 0; m < 4; ++m) { const int row = row0 + ai * 128 + m * 16; const float rs = RSL[wr * 64 + fr + ai * 128 + m * 16] * (1.0f / WSCALE), rs2 = rs * rs, nrl = rs * -1.4426950408889634f;
                f32x4 h[2];
#pragma unroll
                for (int n = 0; n < 2; ++n) { const f32x4 ag = acc[ai][0][m][n], au = acc[ai][1][m][n]; h[n] = (ag * au * rs2) * inv1pexp2(ag * nrl); }
                __builtin_nontemporal_store(pack8_fp8(h[0], h[1]), (u32x2*)(HID + (size_t)row * FF + col0)); }
    }
};
struct EpiDown {
    static constexpr bool MID = false, INIT = false, RSC = true, PREP = false;
    const float* GATEV; unsigned char* Y; const LAS float* RSL;
    __device__ __forceinline__ const float* rsc() const { return GATEV; }
    __device__ __forceinline__ void operator()(const AccT& acc, const pg::Unit& u, int wr, int wc, int fr, int fq) const {
        const int row0 = u.pm * 256 + wr * 64 + fr, col0 = u.pn * 256 + 64 * wc + 8 * fq;
#pragma unroll
        for (int ai = 0; ai < 2; ++ai)
#pragma unroll
            for (int m = 0; m < 4; ++m) { const int row = row0 + ai * 128 + m * 16; const float gt = RSL[wr * 64 + fr + ai * 128 + m * 16] * (YSCALE / WSCALE); unsigned char* yp = Y + (size_t)row * D + col0;
#pragma unroll
                for (int bj = 0; bj < 2; ++bj) *(u32x2*)(yp + 32 * bj) = pack8_fp8(acc[ai][bj][m][0] * gt, acc[ai][bj][m][1] * gt); }
    }
};

__device__ __forceinline__ float wave_sum(float v) {
#pragma unroll
    for (int o = 1; o < 64; o <<= 1) v += __shfl_xor(v, o);
    return v;
}
template <int MAPID> __device__ __forceinline__ int drow(int c) {
    if (MAPID == 0) { if (c < 1792) return 256 * (c >> 8) + inv_bf16(c & 255); if (c < 2816) { const int g = c - 1792; return 256 * (7 + (g >> 7)) + inv_pair(0, g & 127); } const int g = c - 2816; return 256 * (7 + (g >> 7)) + inv_pair(1, g & 127); }
    if (MAPID == 1) return 256 * (c >> 8) + inv_bf16(c & 255);
    if (MAPID == 2) return 256 * (c >> 8) + inv_f32(c & 255);
    if (MAPID == 5) return drow<0>(c + 1024) - 1024;
    if (MAPID == 3) return 256 * (c >> 7) + inv_pair(0, c & 127);
    return 256 * (c >> 7) + inv_pair(1, c & 127);
}
template <int MAPID> __device__ __forceinline__ void p0_item(const float* W, int ld, int nblk, bf16* WT, int Kd, int koff, LAS float* scr, int item, int lane) {
    const int kb = item / nblk, nb = item % nblk, k0 = 64 * kb, n0 = 32 * nb;
    float wv[32];
#pragma unroll
    for (int i = 0; i < 32; ++i) wv[i] = __builtin_nontemporal_load(W + (size_t)(k0 + 2 * i + (lane >> 5)) * ld + n0 + (lane & 31));
#pragma unroll
    for (int i = 0; i < 32; ++i) scr[(2 * i + (lane >> 5)) * 33 + (lane & 31)] = wv[i];
    asm volatile("s_waitcnt lgkmcnt(0)" ::: "memory");
    const int c = lane & 7;
#pragma unroll
    for (int j = 0; j < 4; ++j) { const int n = (lane >> 3) + 8 * j; const LAS float* s = scr + (8 * c) * 33 + n;
        u32x4 o; o.x = pk2(s[0 * 33], s[1 * 33]); o.y = pk2(s[2 * 33], s[3 * 33]); o.z = pk2(s[4 * 33], s[5 * 33]); o.w = pk2(s[6 * 33], s[7 * 33]);
        *(u32x4*)(WT + (size_t)drow<MAPID>(n0 + n) * Kd + koff + k0 + 8 * c) = o; }
    asm volatile("s_waitcnt lgkmcnt(0)" ::: "memory");
}
template <int MAPID> __device__ __forceinline__ void p0_item8(const float* W, int ld, int nblk, unsigned char* WT, int Kd, float scale, LAS float* scr, int item, int lane) {
    const int kb = item / nblk, nb = item % nblk, k0 = 64 * kb, n0 = 32 * nb;
    float wv[32];
#pragma unroll
    for (int i = 0; i < 32; ++i) wv[i] = __builtin_nontemporal_load(W + (size_t)(k0 + 2 * i + (lane >> 5)) * ld + n0 + (lane & 31));
#pragma unroll
    for (int i = 0; i < 32; ++i) scr[(2 * i + (lane >> 5)) * 33 + (lane & 31)] = wv[i] * scale;
    asm volatile("s_waitcnt lgkmcnt(0)" ::: "memory");
    const int c = lane & 7;
#pragma unroll
    for (int j = 0; j < 4; ++j) { const int n = (lane >> 3) + 8 * j; const LAS float* s = scr + (8 * c) * 33 + n;
        const f32x4 a = (f32x4){s[0 * 33], s[1 * 33], s[2 * 33], s[3 * 33]}, b = (f32x4){s[4 * 33], s[5 * 33], s[6 * 33], s[7 * 33]};
        __builtin_nontemporal_store(pack8_fp8(a, b), (u32x2*)(WT + (size_t)drow<MAPID>(n0 + n) * Kd + k0 + 8 * c)); }
    asm volatile("s_waitcnt lgkmcnt(0)" ::: "memory");
}
struct P0Args { float* IRS0; float* IG1; const float *x, *g1, *w_in, *wpa, *wpb, *wout, *wsp, *g2, *wr, *wg, *wu, *wd; bf16 *WIN, *WPROJ, *WOUT, *WSP, *WRH, *WRL; unsigned char *WGU, *WDN; bf16* H; unsigned char *WIN8, *H0F8; };
__device__ __forceinline__ void p0_prologue(LAS unsigned char* lds, const P0Args& a, int gw, int NGW, int wave, int lane, int gtid, int NGT) {
    LAS float* scr = (LAS float*)(lds + wave * 16384);
    constexpr int I_IN = 16 * 120, I_IN8 = 16 * 88, I_PA = 8 * 32, I_OUT = 16 * 32, I_G = 16 * 64, I_D = 32 * 32;
    constexpr int NITEMS = I_IN + I_IN8 + 2 * I_PA + I_OUT + NE * (2 * I_G + I_D);
#ifndef MK_P0W
#define MK_P0W 1
#define MK_P0H 1
#endif
    for (int rpw = 0; rpw < MK_P0W; ++rpw)
    for (int it = gw; it < NITEMS; it += NGW) {
        int r = it;
        if (r < I_IN) { p0_item<0>(a.w_in, INC, 120, a.WIN, D, 0, scr, r, lane); continue; } r -= I_IN;
        if (r < I_IN8) { p0_item8<5>(a.w_in + 1024, INC, 88, a.WIN8, D, WSCALE, scr, r, lane); continue; } r -= I_IN8;
        if (r < I_PA) { p0_item<1>(a.wpa, D, 32, a.WPROJ, AOB / 2, 0, scr, r, lane); continue; } r -= I_PA;
        if (r < I_PA) { p0_item8<1>(a.wpb, D, 32, (unsigned char*)a.WPROJ + 1024, AOB, WSCALE, scr, r, lane); continue; } r -= I_PA;
        if (r < I_OUT) { p0_item<1>(a.wout, D, 32, a.WOUT, D, 0, scr, r, lane); continue; } r -= I_OUT;
        if (r < NE * I_G) { const int e = r / I_G; p0_item8<3>(a.wg + (size_t)e * D * FF, FF, 64, a.WGU + (size_t)e * 4096 * D, D, WSCALE, scr, r % I_G, lane); continue; } r -= NE * I_G;
        if (r < NE * I_G) { const int e = r / I_G; p0_item8<4>(a.wu + (size_t)e * D * FF, FF, 64, a.WGU + (size_t)e * 4096 * D, D, WSCALE, scr, r % I_G, lane); continue; } r -= NE * I_G;
        { const int e = r / I_D; p0_item8<1>(a.wd + (size_t)e * FF * D, D, 32, a.WDN + (size_t)e * D * FF, FF, WSCALE, scr, r % I_D, lane); }
    }
    for (int i = gtid; i < 8 * 128 * 128 / 4; i += NGT) { const f32x4 v = *(const f32x4*)(a.wsp + 4 * (size_t)i); u32x2 o; o.x = pk2(v[0], v[1]); o.y = pk2(v[2], v[3]); *(u32x2*)(a.WSP + 4 * (size_t)i) = o; }
    for (int i = gtid; i < D; i += NGT) a.IG1[i] = 1.0f / a.g1[i];
    for (int i = gtid; i < NE * D; i += NGT) { const int e = i >> 10, k = i & 1023; const float v = a.wr[k * NE + e]; const bf16 h = f2bf(v); a.WRH[i] = h; a.WRL[i] = f2bf(v - bf2f(h)); }
    for (int rph = 0; rph < MK_P0H; ++rph)
    for (int m0 = gw; m0 < T; m0 += 4 * NGW) {
        f32x4 v[4][4]; float ssum[4];
#pragma unroll
        for (int r = 0; r < 4; ++r) { const f32x4* xr = (const f32x4*)(a.x + (size_t)(m0 + r * NGW) * D) + lane;
#pragma unroll
            for (int j = 0; j < 4; ++j) v[r][j] = __builtin_nontemporal_load(xr + 64 * j); }
#pragma unroll
        for (int r = 0; r < 4; ++r) { float s_ = 0.f;
#pragma unroll
            for (int j = 0; j < 4; ++j) s_ += (v[r][j][0] * v[r][j][0] + v[r][j][1] * v[r][j][1]) + (v[r][j][2] * v[r][j][2] + v[r][j][3] * v[r][j][3]);
            ssum[r] = wave_sum(s_); }
#pragma unroll
        for (int r = 0; r < 4; ++r) { const float rstd = rsqrtf(ssum[r] * (1.0f / D) + EPS); if (lane == 0) a.IRS0[m0 + r * NGW] = 1.0f / rstd; u32x2* o8 = (u32x2*)(a.H + (size_t)(m0 + r * NGW) * D) + lane;
#pragma unroll
            for (int j = 0; j < 4; ++j) { const f32x4 gg = *((const f32x4*)a.g1 + lane + 64 * j); const f32x4 y = v[r][j] * rstd * gg; u32x2 o; o.x = pk2(y[0], y[1]); o.y = pk2(y[2], y[3]); o8[64 * j] = o;
                int w8 = 0; w8 = __builtin_amdgcn_cvt_pk_fp8_f32(y[0], y[1], w8, false); w8 = __builtin_amdgcn_cvt_pk_fp8_f32(y[2], y[3], w8, true);
                ((unsigned*)(a.H0F8 + (size_t)(m0 + r * NGW) * D))[lane + 64 * j] = (unsigned)w8; } }
    }
}

__device__ __forceinline__ bf16x8 tr_pair(const LAS unsigned char* p0, const LAS unsigned char* p1) {
    const s16x4 a = __builtin_bit_cast(s16x4, __builtin_amdgcn_ds_read_tr16_b64_v4i16((LAS s16x4*)p0));
    const s16x4 b = __builtin_bit_cast(s16x4, __builtin_amdgcn_ds_read_tr16_b64_v4i16((LAS s16x4*)p1));
    return (bf16x8){a[0], a[1], a[2], a[3], b[0], b[1], b[2], b[3]};
}
constexpr int SP_STRIDE = 144, SP_IMG = 128 * SP_STRIDE, SP_PART = 8 * SP_IMG, SP_RSTD = SP_PART + 8 * 128 * 4, SP_END = SP_RSTD + 512;
__device__ __forceinline__ void spatial_unit(LAS unsigned char* lds, int bc, const bf16* UG, const bf16* VG, const float* vng, const bf16* WSP, const float* bsp, bf16* AO, int wave, int lane, int tid) {
    const int g = wave; const size_t row0 = (size_t)bc * 128;
    LAS unsigned char* img = lds + wave * SP_IMG; LAS float* part = (LAS float*)(lds + SP_PART); LAS float* rstd = (LAS float*)(lds + SP_RSTD);
    const int c8 = lane & 7, qr = lane >> 3;
    u32x4 v[16];
#pragma unroll
    for (int it = 0; it < 16; ++it) v[it] = *(const u32x4*)(VG + (row0 + 8 * it + qr) * AW + g * 64 + c8 * 8);
#pragma unroll
    for (int it = 0; it < 16; ++it) { f32x4 a, b; unpack8(v[it], a, b); float s = (a[0] * a[0] + a[1] * a[1]) + (a[2] * a[2] + a[3] * a[3]) + (b[0] * b[0] + b[1] * b[1]) + (b[2] * b[2] + b[3] * b[3]);
        s += __shfl_xor(s, 1); s += __shfl_xor(s, 2); s += __shfl_xor(s, 4); if (c8 == 0) part[g * 128 + 8 * it + qr] = s; }
    __syncthreads();
    if (tid < 128) { float t = 0.f;
#pragma unroll
        for (int w = 0; w < 8; ++w) t += part[w * 128 + tid];
        rstd[tid] = rsqrtf(t * (1.0f / AW) + EPS); }
    __syncthreads();
    const f32x4 g0 = *(const f32x4*)(vng + g * 64 + c8 * 8), g1 = *(const f32x4*)(vng + g * 64 + c8 * 8 + 4);
#pragma unroll
    for (int it = 0; it < 16; ++it) { const int q = 8 * it + qr; const float r = rstd[q]; f32x4 a, b; unpack8(v[it], a, b); *(LAS u32x4*)(img + q * SP_STRIDE + c8 * 16) = pack8(a * r * g0, b * r * g1); }
    asm volatile("s_waitcnt lgkmcnt(0)" ::: "memory");
    const int fr = lane & 15, fq = lane >> 4, qq = (lane & 15) >> 2, p4 = lane & 3;
    const bf16* wg = WSP + (size_t)g * 128 * 128;
#pragma unroll 1
    for (int nh = 0; nh < 2; ++nh) {
        f32x4 acc[4][4];
        u32x4 uu[4][2]; float bsv[4];
#pragma unroll
        for (int nb = 0; nb < 4; ++nb) { const int p = 64 * nh + 16 * nb + fr; const size_t ro = (row0 + p); bsv[nb] = bsp[g * 128 + p];
            uu[nb][0] = *(const u32x4*)(UG + ro * AW + g * 64 + 16 * fq); uu[nb][1] = *(const u32x4*)(UG + ro * AW + g * 64 + 16 * fq + 8); }
#pragma unroll
        for (int mb = 0; mb < 4; ++mb)
#pragma unroll
            for (int nb = 0; nb < 4; ++nb) acc[mb][nb] = (f32x4){0.f, 0.f, 0.f, 0.f};
#pragma unroll
        for (int kb = 0; kb < 4; ++kb) {
            bf16x8 af[4];
#pragma unroll
            for (int mb = 0; mb < 4; ++mb) { const LAS unsigned char* p = img + (32 * kb + 8 * fq + qq) * SP_STRIDE + (16 * p4 + 4 * mb) * 2; af[mb] = tr_pair(p, p + 4 * SP_STRIDE); }
#pragma unroll
            for (int nb = 0; nb < 4; ++nb) { const bf16x8 bfr = *(const bf16x8*)(wg + (size_t)(64 * nh + 16 * nb + fr) * 128 + 32 * kb + 8 * fq);
#pragma unroll
                for (int mb = 0; mb < 4; ++mb) acc[mb][nb] = __builtin_amdgcn_mfma_f32_16x16x32_bf16(af[mb], bfr, acc[mb][nb], 0, 0, 0); }
        }
#pragma unroll
        for (int nb = 0; nb < 4; ++nb) { const int p = 64 * nh + 16 * nb + fr; const float bs = bsv[nb]; const size_t ro = (row0 + p);
            const u32x4 u0 = uu[nb][0], u1 = uu[nb][1];
            f32x4 ua, ub, uc, ud; unpack8(u0, ua, ub); unpack8(u1, uc, ud);
            bf16* ap_ = (bf16*)((unsigned char*)AO + ro * AOB) + g * 64 + 16 * fq;
            *(u32x4*)ap_ = pack8(ua * (acc[0][nb] + bs), ub * (acc[1][nb] + bs));
            *(u32x4*)(ap_ + 8) = pack8(uc * (acc[2][nb] + bs), ud * (acc[3][nb] + bs)); }
    }
    __syncthreads();
}
constexpr int AT_KSTR = 144, AT_VSTR = 160, AT_ROWS = 400, AT_K = 0, AT_V = AT_ROWS * AT_KSTR, AT_BIAS = AT_V + AT_ROWS * AT_VSTR, AT_BIASN = 304, AT_END = AT_BIAS + 8 * AT_BIASN * 4;
#define AT_LOAD_KV(bn_, kvh_) do { const int b_ = (bn_) >> 4, n_ = (bn_) & 15; _Pragma("unroll") for (int it = 0; it < 7; ++it) { const int c = tid + it * NTHREADS, s_ = c >> 3, ch = c & 7, pos = n_ * 128 - 128 + s_; \
        kv[it] = (u32x4){0u, 0u, 0u, 0u}; vv[it] = (u32x4){0u, 0u, 0u, 0u}; \
        if (s_ < 384 && pos >= 0 && pos < S) { const size_t ro = ((size_t)b_ * S + pos) * KVW + (kvh_) * 64 + ch * 8; kv[it] = *(const u32x4*)(KB + ro); vv[it] = *(const u32x4*)(VB + ro); } } } while (0)
#define AT_QBLOCK(EDGE_) do { \
            const int i0 = 64 * qh + 16 * qb, jb0 = 4 * qh + qb; const size_t qrow = brow + n * 128 + i0 + fr; \
            const bf16x8 q0 = qn0, q1 = qn1; \
            { const bf16* qx = qp + (size_t)((qb + 1) & 3) * 16 * BW; qn0 = *(const bf16x8*)qx; qn1 = *(const bf16x8*)(qx + 32); } \
            f32x4 sc[18]; float sum = 0.f; const LAS float* bl = bh + 16 + 4 * fq - fr; \
_Pragma("unroll") \
            for (int jbi = 0; jbi < 17; ++jbi) { const LAS unsigned char* kp = lds + AT_K + (16 * (jb0 + jbi) + fr) * AT_KSTR + 16 * fq; \
                const bf16x8 k0 = *(const LAS bf16x8*)kp, k1 = *(const LAS bf16x8*)(kp + 64); \
                f32x4 z = (f32x4){bl[16 * jbi], bl[16 * jbi + 1], bl[16 * jbi + 2], bl[16 * jbi + 3]}; \
                z = __builtin_amdgcn_mfma_f32_16x16x32_bf16(k0, q0, z, 0, 0, 0); z = __builtin_amdgcn_mfma_f32_16x16x32_bf16(k1, q1, z, 0, 0, 0); \
_Pragma("unroll") \
                for (int r = 0; r < 4; ++r) { const int xr = 16 * jbi + 4 * fq + r - fr; float p = __builtin_amdgcn_exp2f(z[r]); \
                    if (jbi == 0) p = (xr >= 0) ? p : 0.f; \
                    if (jbi == 16) p = (xr <= 256) ? p : 0.f; \
                    if (EDGE_) { const int pos = n * 128 - 128 + 16 * (jb0 + jbi) + 4 * fq + r; p = (pos >= 0 && pos < S) ? p : 0.f; } \
                    z[r] = p; sum += p; } \
                sc[jbi] = z; } \
            sc[17] = (f32x4){0.f, 0.f, 0.f, 0.f}; \
            sum += __shfl_xor(sum, 16); sum += __shfl_xor(sum, 32); \
            const float inv = fast_rcp(sum + __builtin_amdgcn_exp2f(snk * 1.4426950408889634f)); \
            f32x4 o[4]; \
_Pragma("unroll") \
            for (int mb = 0; mb < 4; ++mb) o[mb] = (f32x4){0.f, 0.f, 0.f, 0.f}; \
_Pragma("unroll") \
            for (int c = 0; c < 9; ++c) { const u32x4 pw = pack8(sc[2 * c], sc[2 * c + 1]); const bf16x8 pf = __builtin_bit_cast(bf16x8, pw); \
                const LAS unsigned char* vp = lds + AT_V + (16 * (jb0 + 2 * c) + 4 * fq + qq) * AT_VSTR + 8 * p4; \
_Pragma("unroll") \
                for (int mb = 0; mb < 4; ++mb) { const bf16x8 vf = tr_pair(vp + 32 * mb, vp + 32 * mb + 16 * AT_VSTR); o[mb] = __builtin_amdgcn_mfma_f32_16x16x32_bf16(vf, pf, o[mb], 0, 0, 0); } } \
            unsigned char* op = (unsigned char*)AO + qrow * AOB + 1024 + h * 64 + 4 * fq; const float invs = inv * OSC; \
_Pragma("unroll") \
            for (int mb = 0; mb < 4; ++mb) { const f32x4 ov = o[mb] * invs; int w8 = 0; w8 = __builtin_amdgcn_cvt_pk_fp8_f32(ov[0], ov[1], w8, false); w8 = __builtin_amdgcn_cvt_pk_fp8_f32(ov[2], ov[3], w8, true); *(unsigned*)(op + 16 * mb) = (unsigned)w8; } \
        } while (0)
__device__ __forceinline__ void attn_units(LAS unsigned char* lds, int bid, int G, const bf16* Q, const bf16* KB, const bf16* VB, const float* sink, bf16* AO, int wave, int lane, int tid) {
    const LAS float* bias = (const LAS float*)(lds + AT_BIAS);
    const int fr = lane & 15, fq = lane >> 4, qq = (lane & 15) >> 2, p4 = lane & 3;
    const int nu = (NB * 16 - bid + G - 1) / G, npass = 2 * nu;
    u32x4 kv[7], vv[7];
    if (npass > 0) AT_LOAD_KV(bid, 0);
#pragma unroll 1
    for (int pp = 0; pp < npass; ++pp) {
        const int bn = bid + (pp >> 1) * G, kvh = pp & 1, b = bn >> 4, n = bn & 15; const size_t brow = (size_t)b * S;
        const int h = 4 * kvh + (wave & 3), qh = wave >> 2; const float snk = sink[h];
        const bf16* qp = Q + (brow + n * 128 + 64 * qh + fr) * BW + h * 64 + 8 * fq;
        bf16x8 qn0 = *(const bf16x8*)qp, qn1 = *(const bf16x8*)(qp + 32);
        __syncthreads();
#pragma unroll
        for (int it = 0; it < 7; ++it) { const int c = tid + it * NTHREADS, s_ = c >> 3, ch = c & 7;
            if (c < AT_ROWS * 8) { *(LAS u32x4*)(lds + AT_K + s_ * AT_KSTR + ch * 16) = kv[it]; *(LAS u32x4*)(lds + AT_V + s_ * AT_VSTR + ch * 16) = vv[it]; } }
        __syncthreads();
        if (pp + 1 < npass) AT_LOAD_KV(bid + ((pp + 1) >> 1) * G, (pp + 1) & 1);
        const bool edge = (n == 0) || (n == 15);
        const LAS float* bh = bias + h * AT_BIASN;
#pragma unroll 1
        for (int qb = 0; qb < 4; ++qb) { if (edge) { AT_QBLOCK(true); } else { AT_QBLOCK(false); } }
    }
}
#undef AT_LOAD_KV
#undef AT_QBLOCK
__device__ __forceinline__ void p2_mixers(LAS unsigned char* lds, int bid, int G, const bf16* UG, const bf16* VG, const float* vng, const bf16* WSP, const float* bsp,
                                          const bf16* Q, const bf16* KB, const bf16* VB, const float* sink, const float* relt, bf16* AO, int wave, int lane, int tid) {
    for (int u = bid; u < NB * 16; u += G) spatial_unit(lds, u, UG, VG, vng, WSP, bsp, AO, wave, lane, tid);
    __syncthreads();
    for (int i = tid; i < 8 * AT_BIASN; i += NTHREADS) { const int h = i / AT_BIASN, xx = i % AT_BIASN, rel = xx - 16 - 128; ((LAS float*)(lds + AT_BIAS))[i] = (rel >= -128 && rel <= 128) ? relt[t5_bucket(rel) * 8 + h] * 1.4426950408889634f : 0.f; }
    attn_units(lds, bid, G, Q, KB, VB, sink, AO, wave, lane, tid);
}

constexpr int P5_WSTR = 2 * D + 16, P5_WL = 16 * P5_WSTR, P5_G = 2 * P5_WL;
__device__ __forceinline__ void p5_router(LAS unsigned char* lds, const bf16* x1, const float* g2, const bf16* WRH, const bf16* WRL, unsigned char* H8, float* AFF, float* RSTD, int gw, int NGW, int lane, int tid) {
    const int fr = lane & 15, fq = lane >> 4;
    u32x4 xw[32];
    if (gw < T / 16) {
#pragma unroll
        for (int kb = 0; kb < 32; ++kb) xw[kb] = *(const u32x4*)(x1 + ((size_t)gw * 16 + fr) * D + 8 * fq + 32 * kb);
    }
    asm volatile("" ::: "memory");
    for (int i = tid; i < 16 * (D / 8); i += NTHREADS) { const int e = i >> 7, c = i & 127;
        *(LAS u32x4*)(lds + e * P5_WSTR + c * 16) = *(const u32x4*)(WRH + e * D + c * 8); *(LAS u32x4*)(lds + P5_WL + e * P5_WSTR + c * 16) = *(const u32x4*)(WRL + e * D + c * 8); }
    for (int i = tid; i < D / 4; i += NTHREADS) *(LAS f32x4*)(lds + P5_G + i * 16) = *(const f32x4*)(g2 + 4 * i);
    __syncthreads();
    const LAS unsigned char* whp = lds + fr * P5_WSTR + 16 * fq; const LAS unsigned char* gp = lds + P5_G + 32 * fq;
    for (int rb = gw; rb < T / 16; rb += NGW) {
        const size_t row = (size_t)rb * 16 + fr; const bf16* xr = x1 + row * D + 8 * fq; unsigned char* hr = H8 + row * D + 8 * fq;
        f32x4 acc = (f32x4){0.f, 0.f, 0.f, 0.f}; float ss = 0.f;
        if (rb != gw) {
#pragma unroll
            for (int kb = 0; kb < 32; ++kb) xw[kb] = *(const u32x4*)(xr + 32 * kb);
            asm volatile("" ::: "memory");
        }
#pragma unroll
        for (int kb = 0; kb < 32; ++kb) {
            f32x4 a0, a1; unpack8(xw[kb], a0, a1);
            const f32x4 ga = *(const LAS f32x4*)(gp + 128 * kb), gb = *(const LAS f32x4*)(gp + 128 * kb + 16);
            ss += (a0[0] * a0[0] + a0[1] * a0[1]) + (a0[2] * a0[2] + a0[3] * a0[3]) + (a1[0] * a1[0] + a1[1] * a1[1]) + (a1[2] * a1[2] + a1[3] * a1[3]);
            const f32x4 y0 = a0 * ga, y1 = a1 * gb;
            const u32x4 hw = pack8(y0, y1); f32x4 h0, h1; unpack8(hw, h0, h1);
            const u32x4 lw = pack8(y0 - h0, y1 - h1);
            *(u32x2*)(hr + 32 * kb) = pack8_fp8(y0, y1);
            const bf16x8 wh = *(const LAS bf16x8*)(whp + 64 * kb), wl = *(const LAS bf16x8*)(whp + P5_WL + 64 * kb);
            const bf16x8 xh = __builtin_bit_cast(bf16x8, hw), xl = __builtin_bit_cast(bf16x8, lw);
            acc = __builtin_amdgcn_mfma_f32_16x16x32_bf16(wh, xh, acc, 0, 0, 0);
            acc = __builtin_amdgcn_mfma_f32_16x16x32_bf16(wh, xl, acc, 0, 0, 0);
            acc = __builtin_amdgcn_mfma_f32_16x16x32_bf16(wl, xh, acc, 0, 0, 0);
        }
        ss += __shfl_xor(ss, 16); ss += __shfl_xor(ss, 32);
        const float rstd = rsqrtf(ss * (1.0f / D) + EPS);
        f32x4 lg = acc * rstd; float mx = fmaxf(fmaxf(lg[0], lg[1]), fmaxf(lg[2], lg[3]));
        mx = fmaxf(mx, __shfl_xor(mx, 16)); mx = fmaxf(mx, __shfl_xor(mx, 32));
        f32x4 e; float sum = 0.f;
#pragma unroll
        for (int r = 0; r < 4; ++r) { e[r] = expf(lg[r] - mx); sum += e[r]; }
        sum += __shfl_xor(sum, 16); sum += __shfl_xor(sum, 32);
        *(f32x4*)(AFF + row * NE + 4 * fq) = e * (1.0f / sum);
        if (fq == 0) RSTD[row] = rstd;
    }
}

__device__ __forceinline__ void p6_topk_item(LAS unsigned char* lds, int item, const float* AFF, const float* RSTD, int* IDX, float* GATEV, float* RS, short* INV, int wave, int lane, int tid) {
    LAS unsigned* hist = (LAS unsigned*)lds; LAS unsigned* sel = hist + 256; LAS unsigned* wtot = hist + 272;
    const int e = item >> 5, b = item & 31;
    unsigned key[4]; float val[4];
    const f32x4 rs4 = *(const f32x4*)(RSTD + (size_t)b * S + 4 * tid);
#pragma unroll
    for (int j = 0; j < 4; ++j) { val[j] = AFF[((size_t)b * S + 4 * tid + j) * NE + e]; key[j] = __float_as_uint(val[j]); }
    unsigned prefix = 0u, krem = CAP;
#pragma unroll 1
    for (int pass = 0; pass < 4; ++pass) {
        const int shift = 24 - 8 * pass;
        if (tid < 256) hist[tid] = 0u;
        __syncthreads();
#pragma unroll
        for (int j = 0; j < 4; ++j) if (pass == 0 || (key[j] >> (shift + 8)) == prefix) __hip_atomic_fetch_add(&hist[(key[j] >> shift) & 255u], 1u, __ATOMIC_RELAXED, __HIP_MEMORY_SCOPE_WORKGROUP);
        __syncthreads();
        if (wave == 0) {
            unsigned c[4];
#pragma unroll
            for (int j = 0; j < 4; ++j) c[j] = hist[4 * lane + j];
            const unsigned tot = c[0] + c[1] + c[2] + c[3]; unsigned sfx = tot;
#pragma unroll
            for (int o = 1; o < 64; o <<= 1) { const unsigned t = __shfl_down(sfx, o); if (lane + o < 64) sfx += t; }
            unsigned cum = sfx - tot;
#pragma unroll
            for (int j = 3; j >= 0; --j) { if (cum < krem && krem <= cum + c[j]) { sel[0] = 4u * lane + j; sel[1] = krem - cum; } cum += c[j]; }
        }
        __syncthreads();
        prefix = (prefix << 8) | sel[0]; krem = sel[1];
    }
    unsigned ngt = 0u, neq = 0u;
#pragma unroll
    for (int j = 0; j < 4; ++j) { ngt += key[j] > prefix; neq += key[j] == prefix; }
    unsigned pk = ngt | (neq << 16), inc = pk;
#pragma unroll
    for (int o = 1; o < 64; o <<= 1) { const unsigned t = __shfl_up(inc, o); if (lane >= o) inc += t; }
    if (lane == 63) wtot[wave] = inc;
    __syncthreads();
    unsigned base = inc - pk;
    for (int w = 0; w < wave; ++w) base += wtot[w];
    unsigned gi = base & 0xffffu, ei = base >> 16; const unsigned ngt_tot = CAP - krem;
#pragma unroll
    for (int j = 0; j < 4; ++j) { int slot = -1;
        if (key[j] > prefix) slot = (int)gi++; else if (key[j] == prefix) { if (ei < krem) slot = (int)(ngt_tot + ei); ++ei; }
        const int tok = b * S + 4 * tid + j; INV[(size_t)tok * NE + e] = (short)slot;
        if (slot >= 0) { const size_t r = (size_t)item * CAP + slot; IDX[r] = tok; GATEV[r] = val[j]; RS[r] = rs4[j]; } }
    __syncthreads();
}

__device__ __forceinline__ void p9_combine(const short* INV, const unsigned char* Y, const bf16* X1B, float* out, int gw, int NGW, int lane) {
    for (int t0 = gw; t0 < T; t0 += 2 * NGW) {
        f32x4 v[2][4]; int myslot[2]; unsigned long long mask[2];
#pragma unroll
        for (int r = 0; r < 2; ++r) { const int t = t0 + r * NGW; const u32x2* xp = (const u32x2*)(X1B + (size_t)t * D) + lane;
#pragma unroll
            for (int j = 0; j < 4; ++j) { const u32x2 w = __builtin_nontemporal_load(xp + 64 * j); v[r][j] = (f32x4){bflo2f(w.x), bfhi2f(w.x), bflo2f(w.y), bfhi2f(w.y)}; }
            myslot[r] = (lane < NE) ? (int)INV[(size_t)t * NE + lane] : -1; }
#pragma unroll
        for (int r = 0; r < 2; ++r) mask[r] = __ballot(myslot[r] >= 0);
        while (mask[0] | mask[1]) {
            unsigned w[2][2][4]; bool has[2][2];
#pragma unroll
            for (int r = 0; r < 2; ++r)
#pragma unroll
                for (int q = 0; q < 2; ++q) { has[r][q] = mask[r] != 0ull;
                    if (has[r][q]) { const int e = __builtin_ctzll(mask[r]); mask[r] &= mask[r] - 1; const int slot = __shfl(myslot[r], e); const int b = (t0 + r * NGW) >> 11;
                        const unsigned* yp = (const unsigned*)(Y + ((size_t)(e * NB + b) * CAP + slot) * D) + lane;
#pragma unroll
                        for (int j = 0; j < 4; ++j) w[r][q][j] = __builtin_nontemporal_load(yp + 64 * j); } }
#pragma unroll
            for (int r = 0; r < 2; ++r)
#pragma unroll
                for (int q = 0; q < 2; ++q) if (has[r][q]) {
#pragma unroll
                    for (int j = 0; j < 4; ++j) { const f32x2 lo = __builtin_amdgcn_cvt_pk_f32_fp8((int)w[r][q][j], false), hi = __builtin_amdgcn_cvt_pk_f32_fp8((int)w[r][q][j], true);
                        v[r][j] += (f32x4){lo[0], lo[1], hi[0], hi[1]} * (1.0f / YSCALE); } }
        }
#pragma unroll
        for (int r = 0; r < 2; ++r) { f32x4* op = (f32x4*)(out + (size_t)(t0 + r * NGW) * D) + lane;
#pragma unroll
            for (int j = 0; j < 4; ++j) __builtin_nontemporal_store(v[r][j], op + 64 * j); }
    }
}

constexpr int LDS_CTL_OFF = 155648, LDS_BYTES = LDS_CTL_OFF + 256;
static_assert(SP_END <= LDS_CTL_OFF && AT_END <= LDS_CTL_OFF && pg::LTAB_OFF + pg::LTAB_BYTES <= LDS_CTL_OFF && LDS_BYTES <= 163840, "LDS map");
constexpr int NPHASE = 10;
#ifndef MK_REV8
#define MK_REV8 1
#endif
#ifndef MK_WGM7
#define MK_WGM7 4
#define MK_WGM8 4
#endif
#ifndef MK_REPEAT
#define MK_REPEAT -1
#endif
struct Args { const float* in[19]; float* out; unsigned char* ws; int ph_lo, ph_hi, li, pad; };
typedef const Args __attribute__((address_space(4))) CArgs;
__global__ void __launch_bounds__(NTHREADS, 2) mk_fwd(Args) {
    extern __shared__ __attribute__((aligned(16))) unsigned char lds_raw[];
    LAS unsigned char* lds = (LAS unsigned char*)lds_raw;
    CArgs* ap0 = (CArgs*)__builtin_amdgcn_kernarg_segment_ptr();
    const int tid = threadIdx.x, lane = tid & 63, wave = __builtin_amdgcn_readfirstlane(tid >> 6);
    const int G = gridDim.x, bid = blockIdx.x;
    const int gw = bid * NWAVES + wave, NGW = G * NWAVES, gtid = bid * NTHREADS + tid, NGT = G * NTHREADS;
    if (tid < 64) ((LAS unsigned*)(lds + LDS_CTL_OFF))[tid] = 0u;
    __syncthreads();
    const int lo = ap0->ph_lo, hi = ap0->ph_hi;
    XcdBarrier bar = xcd_barrier_post((unsigned*)(ap0->ws + WS_CTL) + CW_BAR + ap0->li * XCD_BAR_WORDS, (volatile LAS unsigned*)(lds + LDS_CTL_OFF));
#define IN(k) (lo <= (k) && (k) < hi)
#define SEAM(k) do { if (IN(k) && IN((k) + 1)) xcd_barrier(bar); } while (0)
#define PH CArgs* ap = ap0; asm volatile("" : "+s"(ap)); unsigned char* const ws = ap->ws; (void)ws
#define WSP(T_, off) ((T_*)(ws + (off)))
#define DUP(k, ...) __VA_ARGS__

#define BODY0 { PH; P0Args a{WSP(float, WS_RSTD0), WSP(float, WS_IG1), ap->in[0], ap->in[1], ap->in[2], ap->in[11], ap->in[12], ap->in[13], ap->in[5], ap->in[14], ap->in[15], ap->in[16], ap->in[17], ap->in[18], WSP(bf16, WS_WIN), WSP(bf16, WS_WPROJ), WSP(bf16, WS_WOUT), \
        WSP(bf16, WS_WSP), WSP(bf16, WS_WRH), WSP(bf16, WS_WRL), ws + WS_WGU, ws + WS_WDN, WSP(bf16, WS_H), ws + WS_WIN8, ws + WS_H0F8}; p0_prologue(lds, a, gw, NGW, wave, lane, gtid, NGT); }
#define BODY1 { PH; { pg::Prob g{(const char*)(ws + WS_H), nullptr, (const char*)(ws + WS_WIN), D * 2, 31, 0}; pg::StaticOrder So; So.init(T, 1024, G, bid); \
        EpiInT<false> E{WSP(bf16, WS_UG), WSP(bf16, WS_VG), WSP(bf16, WS_Q), WSP(bf16, WS_K), WSP(bf16, WS_VB), WSP(unsigned short, WS_R), ap->in[3], ap->in[7], ap->in[8], (LAS float*)(lds + pg::LTAB_OFF)}; pg::gemm_phase<EpiInT<false>, false, false>(lds, g, So, E); } \
        { pg::Prob g{(const char*)(ws + WS_H0F8), nullptr, (const char*)(ws + WS_WIN8), D, 31, 0}; pg::StaticOrder So; So.init(T, 2816, G, bid); \
        EpiInT<true> E{WSP(bf16, WS_UG), WSP(bf16, WS_VG), WSP(bf16, WS_Q), WSP(bf16, WS_K), WSP(bf16, WS_VB), WSP(unsigned short, WS_R), ap->in[3], ap->in[7], ap->in[8], (LAS float*)(lds + pg::LTAB_OFF)}; pg::gemm_phase<EpiInT<true>, true, false>(lds, g, So, E); } }
#define BODY2 { PH; p2_mixers(lds, bid, G, WSP(bf16, WS_UG), WSP(bf16, WS_VG), ap->in[4], WSP(bf16, WS_WSP), ap->in[6], WSP(bf16, WS_Q), WSP(bf16, WS_K), WSP(bf16, WS_VB), ap->in[9], ap->in[10], WSP(bf16, WS_AO), wave, lane, tid); }
#define BODY3 { PH; pg::Prob g{(const char*)(ws + WS_AO), nullptr, (const char*)(ws + WS_WPROJ), AOB, 31, 0}; pg::StaticOrder So; So.init(T, D, G, bid); \
        EpiProj E{WSP(unsigned short, WS_R), WSP(bf16, WS_MG)}; pg::gemm_phase<EpiProj, 2, false>(lds, g, So, E); }
#define BODY4 { PH; pg::Prob g{(const char*)(ws + WS_MG), nullptr, (const char*)(ws + WS_WOUT), D * 2, 31, 0}; pg::StaticOrder So; So.init(T, D, G, bid); \
        EpiOut E{WSP(bf16, WS_H), WSP(float, WS_RSTD0), WSP(float, WS_IG1), WSP(bf16, WS_X1B)}; pg::gemm_phase<EpiOut, false, false>(lds, g, So, E); }
#define BODY5 { PH; p5_router(lds, WSP(bf16, WS_X1B), ap->in[14], WSP(bf16, WS_WRH), WSP(bf16, WS_WRL), ws + WS_H, WSP(float, WS_AFF), WSP(float, WS_RSTD), gw, NGW, lane, tid); __syncthreads(); }
#define BODY6 { PH; for (int it = bid; it < NE * NB; it += G) p6_topk_item(lds, it, WSP(float, WS_AFF), WSP(float, WS_RSTD), WSP(int, WS_IDX), WSP(float, WS_GATEV), WSP(float, WS_RS), WSP(short, WS_INV), wave, lane, tid); }
#define BODY7 { PH; pg::Prob g{(const char*)(ws + WS_H), WSP(int, WS_IDX), (const char*)(ws + WS_WGU), D, 5, (size_t)4096 * D}; pg::StaticOrder So; So.init(NSLOT, 4096, G, bid, MK_WGM7); \
        EpiGU E{WSP(float, WS_RS), ws + WS_HID, (const LAS float*)(lds + pg::RSC_OFF)}; pg::gemm_phase<EpiGU, true, true>(lds, g, So, E); }
#define BODY8 { PH; pg::Prob g{(const char*)(ws + WS_HID), nullptr, (const char*)(ws + WS_WDN), FF, 5, (size_t)D * FF}; pg::StaticOrder So; So.init(NSLOT, D, G, bid, MK_WGM8, MK_REV8); \
        EpiDown E{WSP(float, WS_GATEV), ws + WS_Y, (const LAS float*)(lds + pg::RSC_OFF)}; pg::gemm_phase<EpiDown, true, false>(lds, g, So, E); }
#define BODY9 { PH; int t9 = threadIdx.x; asm volatile("" : "+v"(t9)); p9_combine(WSP(short, WS_INV), ws + WS_Y, WSP(bf16, WS_X1B), ap->out, bid * NWAVES + __builtin_amdgcn_readfirstlane(t9 >> 6), NGW, t9 & 63); }
#define RUN(k, BODY) do { if (IN(k)) { BODY if (MK_REPEAT == (k)) { xcd_barrier(bar); BODY } } } while (0)
    RUN(0, BODY0); SEAM(0);
    RUN(1, BODY1);
    SEAM(1);
    RUN(2, BODY2); SEAM(2);
    RUN(3, BODY3); SEAM(3);
    RUN(4, BODY4); SEAM(4);
    RUN(5, BODY5); SEAM(5);
    RUN(6, BODY6); SEAM(6);
    RUN(7, BODY7);
    SEAM(7);
    RUN(8, BODY8); SEAM(8);
    if (IN(9)) BODY9
#undef IN
#undef SEAM
#undef PH
#undef WSP
#undef RUN
}

extern "C" void kernel_launch(void* const* d_in, const int* in_sizes, int n_in, void* d_out, int out_size, void* d_ws, size_t ws_size, hipStream_t stream) {
    static int grid = 0;
    if (grid == 0) {
        if (n_in != 19 || out_size != T * D || ws_size < WS_END) { fprintf(stderr, "kernel_launch: unexpected problem shape (n_in %d, out %d, ws %zu)\n", n_in, out_size, ws_size); grid = -1; return; }
        int dev = 0, cus = 0, per_cu = 0;
        if (hipGetDevice(&dev) != hipSuccess || hipDeviceGetAttribute(&cus, hipDeviceAttributeMultiprocessorCount, dev) != hipSuccess) { grid = -1; return; }
        if (hipFuncSetAttribute((const void*)mk_fwd, hipFuncAttributeMaxDynamicSharedMemorySize, LDS_BYTES) != hipSuccess) { fprintf(stderr, "kernel_launch: hipFuncSetAttribute failed\n"); grid = -1; return; }
        if (hipOccupancyMaxActiveBlocksPerMultiprocessor(&per_cu, (const void*)mk_fwd, NTHREADS, LDS_BYTES) != hipSuccess || per_cu < 1) fprintf(stderr, "kernel_launch: occupancy query reports %d\n", per_cu);
        (void)hipGetLastError();
        if (cus < 256) { fprintf(stderr, "kernel_launch: built for a 256-CU device (%d CUs found); nothing launched\n", cus); grid = -1; return; }
        grid = 256;
    }
    if (grid < 0) return;
    (void)hipMemsetAsync((char*)d_ws + WS_CTL, 0, CTL_ZERO_BYTES, stream);
    Args a{};
    for (int i = 0; i < 19; ++i) a.in[i] = (const float*)d_in[i];
    a.out = (float*)d_out; a.ws = (unsigned char*)d_ws;
    a.ph_lo = 0; a.ph_hi = NPHASE; a.li = 0; a.pad = 0;
    hipLaunchKernelGGL(mk_fwd, dim3(grid), dim3(NTHREADS), LDS_BYTES, stream, a);
}
```
